# Optimizing an MI355X kernel written in HIP

```python
import math
import jax, jax.numpy as jnp
from jax import lax
import numpy as np

D_MODEL = 1024
BATCH = 2
SEQ = 8192
DEPTH = 1
DEC_BATCH = 128
DEC_SEQ = 1
PAST_LEN = 2048
PAGE_SIZE = 128

D_MIX = D_MODEL
HEAD_DIM = 64
D_A = D_MIX // 2
D_B = D_MIX - D_A
A_GROUPS = D_A // HEAD_DIM
CHUNK = 128
N_HEADS = D_B // HEAD_DIM
N_KV = 2
GQA = N_HEADS // N_KV
KV_W = N_KV * HEAD_DIM
ROT_DIM = HEAD_DIM // 4
ROPE_THETA = 500000.0
CMP_BLOCK = 32
CMP_STRIDE = 16
SEL_BLOCK = 64
N_SELECT = 16
WINDOW = 512
Q_BLOCK = 128
NORM_EPS = 1e-6
FORCE_SCORE = 1e4
NEG = -1e30
PROJ_SIZES = (D_A, D_A, D_A, D_B, KV_W, KV_W, KV_W, KV_W, KV_W, KV_W, 3 * N_HEADS, D_B)

kernel_name = 'hybrid_gmlp_nsa_decoder_step'


def rms_norm(x, g):
    xf = x.astype(jnp.float32)
    y = xf * lax.rsqrt(jnp.mean(xf * xf, -1, keepdims=True) + NORM_EPS)
    return (y * g.astype(jnp.float32)).astype(x.dtype)


def layer_norm(x, g, b):
    xf = x.astype(jnp.float32)
    xc = xf - jnp.mean(xf, -1, keepdims=True)
    y = xc * lax.rsqrt(jnp.mean(xc * xc, -1, keepdims=True) + NORM_EPS)
    return (y * g.astype(jnp.float32) + b.astype(jnp.float32)).astype(x.dtype)


def rope(x, pos):
    half = ROT_DIM // 2
    inv = jnp.power(jnp.float32(ROPE_THETA), -jnp.arange(half, dtype=jnp.float32) / half)
    ang = pos.astype(jnp.float32)[:, None] * inv[None, :]
    cos = jnp.cos(ang)[:, None, :]
    sin = jnp.sin(ang)[:, None, :]
    xr = x[..., :ROT_DIM].astype(jnp.float32)
    x1, x2 = xr[..., :half], xr[..., half:]
    rot = jnp.concatenate([x1 * cos - x2 * sin, x2 * cos + x1 * sin], -1).astype(x.dtype)
    return jnp.concatenate([rot, x[..., ROT_DIM:]], -1)


def split_projection(hn, w_in, pos):
    Bn, T = hn.shape[0], hn.shape[1]
    z = jnp.einsum('btd,de->bte', hn, w_in)
    offs = []
    acc = 0
    for s in PROJ_SIZES[:-1]:
        acc += s
        offs.append(acc)
    u, v, z_a, q, kc, vc, ks, vs, kw, vw, g, z_b = jnp.split(z, offs, axis=-1)
    heads = lambda a, n: a.reshape(Bn, T, n, HEAD_DIM)
    q = rope(heads(q, N_HEADS), pos)
    ks = rope(heads(ks, N_KV), pos)
    kw = rope(heads(kw, N_KV), pos)
    gates = jax.nn.sigmoid(g.astype(jnp.float32)).reshape(Bn, T, N_HEADS, 3).astype(hn.dtype)
    return (u, v, z_a, q, heads(kc, N_KV), heads(vc, N_KV), ks, heads(vs, N_KV),
            kw, heads(vw, N_KV), gates, z_b)


def spatial_gate(v, w_s, b_s):
    Bn, T = v.shape[0], v.shape[1]
    lc = min(CHUNK, T)
    n_chunk = -(-T // lc)
    pad = n_chunk * lc - T
    vp = jnp.pad(v, ((0, 0), (0, pad), (0, 0), (0, 0))).reshape(Bn, n_chunk, lc, A_GROUPS, HEAD_DIM)
    w = w_s[:, :lc, :lc] * jnp.tril(jnp.ones((lc, lc), w_s.dtype))
    s = jnp.einsum('gts,bnsgc->bntgc', w, vp) + b_s[:, :lc].T[None, None, :, :, None]
    return s.reshape(Bn, n_chunk * lc, A_GROUPS, HEAD_DIM)[:, :T]


def gmlp_branch(u, v, z_a, ln_g, ln_b, w_s, b_s):
    Bn, T = u.shape[0], u.shape[1]
    vn = layer_norm(v, ln_g, ln_b)
    s = spatial_gate(vn.reshape(Bn, T, A_GROUPS, HEAD_DIM), w_s, b_s).reshape(Bn, T, D_A)
    return u * s * jax.nn.silu(z_a), vn


def compress(k_raw, w_c, pe_c):
    L = k_raw.shape[1]
    n_cmp = (L - CMP_BLOCK) // CMP_STRIDE + 1
    starts = jnp.arange(n_cmp, dtype=jnp.int32) * CMP_STRIDE
    idx = starts[:, None] + jnp.arange(CMP_BLOCK, dtype=jnp.int32)[None, :]
    blocks = k_raw[:, idx] + pe_c[None, None, :, None, :]
    return jnp.einsum('bnlhd,lde->bnhe', blocks, w_c), starts


def to_blocks(k):
    Bn, L = k.shape[0], k.shape[1]
    n_blk = -(-L // SEL_BLOCK)
    kp = jnp.pad(k, ((0, 0), (0, n_blk * SEL_BLOCK - L), (0, 0), (0, 0)))
    return kp.reshape(Bn, n_blk, SEL_BLOCK, N_KV, HEAD_DIM).transpose(0, 3, 1, 2, 4)


def nsa_core(q, q_pos, gates, kc, vc, c_end, kb, vb, kw, vw, kw_pos):
    Bn, Tq = q.shape[0], q.shape[1]
    scale = HEAD_DIM ** -0.5
    qg = q.reshape(Bn, Tq, N_KV, GQA, HEAD_DIM)
    t = q_pos[:, None]
    m_c = (c_end[None, :] <= t)[None, :, None, None, :]
    s_c = jnp.einsum('bqhgd,bnhd->bqhgn', qg, kc).astype(jnp.float32) * scale
    p_c = jax.nn.softmax(jnp.where(m_c, s_c, NEG), -1) * m_c
    o_c = jnp.einsum('bqhgn,bnhd->bqhgd', p_c.astype(vc.dtype), vc)
    n_blk = kb.shape[2]
    cs = c_end - (CMP_BLOCK - 1)
    bs = jnp.arange(n_blk, dtype=jnp.int32) * SEL_BLOCK
    overlap = ((cs[:, None] < bs[None, :] + SEL_BLOCK) & (cs[:, None] + CMP_BLOCK > bs[None, :])).astype(jnp.float32)
    imp = jnp.einsum('bqhgn,nk->bqhk', p_c, overlap)
    blk = jnp.arange(n_blk, dtype=jnp.int32)[None, :]
    cur = t // SEL_BLOCK
    forced = ((blk == 0) | (blk == cur) | (blk == cur - 1))[None, :, None, :]
    valid = (bs[None, :] <= t)[None, :, None, :]
    imp = jnp.where(valid, jnp.where(forced, imp + FORCE_SCORE, imp), -jnp.inf)
    n_top = min(N_SELECT, n_blk)
    _, sel = lax.top_k(imp, n_top)
    sel_t = sel.transpose(0, 2, 1, 3)
    gather = jax.vmap(jax.vmap(lambda kk, ii: kk[ii]))
    kg = gather(kb, sel_t)
    vg = gather(vb, sel_t)
    tok = sel_t[..., None] * SEL_BLOCK + jnp.arange(SEL_BLOCK, dtype=jnp.int32)
    m_s = (tok <= q_pos[None, None, :, None, None]).transpose(0, 2, 1, 3, 4)[:, :, :, None]
    s_s = jnp.einsum('bqhgd,bhqksd->bqhgks', qg, kg).astype(jnp.float32) * scale
    p_s = jax.nn.softmax(jnp.where(m_s, s_s, NEG), axis=(-2, -1))
    o_s = jnp.einsum('bqhgks,bhqksd->bqhgd', p_s.astype(vg.dtype), vg)
    kp = kw_pos[None, :]
    m_w = ((kp <= t) & (kp > t - WINDOW) & (kp >= 0))[None, :, None, None, :]
    s_w = jnp.einsum('bqhgd,blhd->bqhgl', qg, kw).astype(jnp.float32) * scale
    p_w = jax.nn.softmax(jnp.where(m_w, s_w, NEG), -1)
    o_w = jnp.einsum('bqhgl,blhd->bqhgd', p_w.astype(vw.dtype), vw)
    gq = gates.reshape(Bn, Tq, N_KV, GQA, 3)
    o = gq[..., 0:1] * o_c + gq[..., 1:2] * o_s + gq[..., 2:3] * o_w
    return o.reshape(Bn, Tq, N_HEADS, HEAD_DIM)


def merge_out(x, a_out, o_b, z_b, w_out):
    Bn, T = x.shape[0], x.shape[1]
    mix = jnp.concatenate([a_out, o_b.reshape(Bn, T, D_B) * jax.nn.silu(z_b)], -1)
    return x + jnp.einsum('bte,ed->btd', mix, w_out)


def prompt_layer(x, norm_g, w_in, ln_v_g, ln_v_b, w_s, b_s, w_ck, pe_ck, w_cv, pe_cv, w_out):
    Bn, T = x.shape[0], x.shape[1]
    pos = jnp.arange(T, dtype=jnp.int32)
    hn = rms_norm(x, norm_g)
    u, v, z_a, q, kc, vc, ks, vs, kw, vw, gates, z_b = split_projection(hn, w_in, pos)
    a_out, _ = gmlp_branch(u, v, z_a, ln_v_g, ln_v_b, w_s, b_s)
    kcc, starts = compress(kc, w_ck, pe_ck)
    kcc = rope(kcc, starts)
    vcc, _ = compress(vc, w_cv, pe_cv)
    c_end = starts + CMP_BLOCK - 1
    kb, vb = to_blocks(ks), to_blocks(vs)
    padw = ((0, 0), (WINDOW, 0), (0, 0), (0, 0))
    kw_pad, vw_pad = jnp.pad(kw, padw), jnp.pad(vw, padw)
    n_qb = T // Q_BLOCK
    q_blocks = jnp.moveaxis(q.reshape(Bn, n_qb, Q_BLOCK, N_HEADS, HEAD_DIM), 1, 0)
    g_blocks = jnp.moveaxis(gates.reshape(Bn, n_qb, Q_BLOCK, N_HEADS, 3), 1, 0)
    q0s = jnp.arange(n_qb, dtype=jnp.int32) * Q_BLOCK

    def block_fn(args):
        qb, gb, q0 = args
        qpos = q0 + jnp.arange(Q_BLOCK, dtype=jnp.int32)
        kwb = lax.dynamic_slice_in_dim(kw_pad, q0, WINDOW + Q_BLOCK, axis=1)
        vwb = lax.dynamic_slice_in_dim(vw_pad, q0, WINDOW + Q_BLOCK, axis=1)
        kwpos = q0 - WINDOW + jnp.arange(WINDOW + Q_BLOCK, dtype=jnp.int32)
        return nsa_core(qb, qpos, gb, kcc, vcc, c_end, kb, vb, kwb, vwb, kwpos)

    o_b = lax.map(block_fn, (q_blocks, g_blocks, q0s))
    o_b = jnp.moveaxis(o_b, 0, 1).reshape(Bn, T, N_HEADS, HEAD_DIM)
    y = merge_out(x, a_out, o_b, z_b, w_out)
    keep = min(WINDOW, T)
    return y, (kc, vc, ks, vs, kw[:, T - keep:], vw[:, T - keep:])


def sample_layer(x, ck_cmp, cv_cmp, ck_sel, cv_sel, ck_win, cv_win, page_table,
                 norm_g, w_in, ln_v_g, ln_v_b, w_s, b_s, w_ck, pe_ck, w_cv, pe_cv, w_out):
    Bn, T = x.shape[0], x.shape[1]
    past = page_table.shape[1] * PAGE_SIZE
    pos = past + jnp.arange(T, dtype=jnp.int32)
    hn = rms_norm(x, norm_g)
    u, v, z_a, q, kc, vc, ks, vs, kw, vw, gates, z_b = split_projection(hn, w_in, pos)
    a_out, vn = gmlp_branch(u, v, z_a, ln_v_g, ln_v_b, w_s, b_s)
    pages = lambda c: c[page_table].reshape(Bn, past, N_KV, HEAD_DIM)
    kc_full = jnp.concatenate([pages(ck_cmp), kc], 1)
    vc_full = jnp.concatenate([pages(cv_cmp), vc], 1)
    ks_full = jnp.concatenate([pages(ck_sel), ks], 1)
    vs_full = jnp.concatenate([pages(cv_sel), vs], 1)
    kcc, starts = compress(kc_full, w_ck, pe_ck)
    kcc = rope(kcc, starts)
    vcc, _ = compress(vc_full, w_cv, pe_cv)
    c_end = starts + CMP_BLOCK - 1
    kb, vb = to_blocks(ks_full), to_blocks(vs_full)
    keep = ck_win.shape[1]
    kw_all = jnp.concatenate([ck_win, kw], 1)
    vw_all = jnp.concatenate([cv_win, vw], 1)
    kwpos = past - keep + jnp.arange(keep + T, dtype=jnp.int32)
    o_b = nsa_core(q, pos, gates, kcc, vcc, c_end, kb, vb, kw_all, vw_all, kwpos)
    y = merge_out(x, a_out, o_b, z_b, w_out)
    return y, (kc, vc, ks, vs, kw_all[:, T:], vw_all[:, T:], vn)


def setup_inputs(seed: int = 0) -> dict:
    key = jax.random.key(seed)
    ks = jax.random.split(key, 24)
    n_pages = PAST_LEN // PAGE_SIZE
    n_used = DEC_BATCH * n_pages
    n_pool = n_used + n_used // 4
    win_keep = min(WINDOW, PAST_LEN)
    d_in = sum(PROJ_SIZES)
    nrm = lambda k, shape, s: jax.random.normal(k, shape, jnp.float32) * s
    page_table = jax.random.permutation(ks[0], n_pool)[:n_used].reshape(DEC_BATCH, n_pages).astype(jnp.int32)
    paged = (DEPTH, n_pool, PAGE_SIZE, N_KV, HEAD_DIM)
    win = (DEPTH, DEC_BATCH, win_keep, N_KV, HEAD_DIM)
    return {
        'x_prompt': nrm(ks[1], (BATCH, SEQ, D_MODEL), 1.0),
        'x_sample': nrm(ks[2], (DEC_BATCH, DEC_SEQ, D_MODEL), 1.0),
        'cache_k_cmp': nrm(ks[3], paged, 1.0),
        'cache_v_cmp': nrm(ks[4], paged, 1.0),
        'cache_k_sel': nrm(ks[5], paged, 1.0),
        'cache_v_sel': nrm(ks[6], paged, 1.0),
        'cache_k_win': nrm(ks[7], win, 1.0),
        'cache_v_win': nrm(ks[8], win, 1.0),
        'page_table': page_table,
        'norm_g': 1.0 + nrm(ks[9], (DEPTH, D_MODEL), 0.02),
        'w_in': nrm(ks[10], (DEPTH, D_MODEL, d_in), D_MODEL ** -0.5),
        'ln_v_g': 1.0 + nrm(ks[11], (DEPTH, D_A), 0.02),
        'ln_v_b': nrm(ks[12], (DEPTH, D_A), 0.02),
        'w_s': nrm(ks[13], (DEPTH, A_GROUPS, CHUNK, CHUNK), CHUNK ** -0.5),
        'b_s': 1.0 + nrm(ks[14], (DEPTH, A_GROUPS, CHUNK), 0.02),
        'w_ck': nrm(ks[15], (DEPTH, CMP_BLOCK, HEAD_DIM, HEAD_DIM), (CMP_BLOCK * HEAD_DIM) ** -0.5),
        'pe_ck': nrm(ks[16], (DEPTH, CMP_BLOCK, HEAD_DIM), 0.02),
        'w_cv': nrm(ks[17], (DEPTH, CMP_BLOCK, HEAD_DIM, HEAD_DIM), (CMP_BLOCK * HEAD_DIM) ** -0.5),
        'pe_cv': nrm(ks[18], (DEPTH, CMP_BLOCK, HEAD_DIM), 0.02),
        'w_out': nrm(ks[19], (DEPTH, D_MIX, D_MODEL), D_MIX ** -0.5),
        'final_g': 1.0 + nrm(ks[20], (D_MODEL,), 0.02),
    }


def reference(x_prompt, x_sample, cache_k_cmp, cache_v_cmp, cache_k_sel, cache_v_sel,
              cache_k_win, cache_v_win, page_table, norm_g, w_in, ln_v_g, ln_v_b, w_s, b_s,
              w_ck, pe_ck, w_cv, pe_cv, w_out, final_g):
    hp, hs = x_prompt, x_sample
    sp = [[] for _ in range(6)]
    ss = [[] for _ in range(7)]
    for l in range(DEPTH):
        w = (norm_g[l], w_in[l], ln_v_g[l], ln_v_b[l], w_s[l], b_s[l],
             w_ck[l], pe_ck[l], w_cv[l], pe_cv[l], w_out[l])
        hp, st_p = prompt_layer(hp, *w)
        hs, st_s = sample_layer(hs, cache_k_cmp[l], cache_v_cmp[l], cache_k_sel[l], cache_v_sel[l],
                                cache_k_win[l], cache_v_win[l], page_table, *w)
        for i in range(6):
            sp[i].append(st_p[i])
        for i in range(7):
            ss[i].append(st_s[i])
    y_prompt = rms_norm(hp, final_g)
    y_sample = rms_norm(hs, final_g)
    sp = [jnp.stack(a, 0) for a in sp]
    ss = [jnp.stack(a, 0) for a in ss]
    return (y_prompt, y_sample, sp[0], sp[1], sp[2], sp[3], sp[4], sp[5],
            ss[0], ss[1], ss[2], ss[3], ss[4], ss[5], ss[6])
```

```cpp
#include <hip/hip_runtime.h>
#include <stdint.h>
#include <cmath>

constexpr int DM = 1024, NB = 2, SEQ = 8192, NP = NB * SEQ, DEC = 128, NR = NP + DEC;
constexpr int PAST = 2048, PAGE = 128, NPAGES = 16;
constexpr int DIN = 3352;
constexpr int C_U = 0, C_V = 512, C_ZA = 1024, C_Q = 1536, C_KC = 2048, C_VC = 2176, C_KS = 2304, C_VS = 2432,
              C_KW = 2560, C_VW = 2688, C_G = 2816, C_ZB = 2840;
constexpr int NCMP_P = 511, NCMP_S = 127, NBLK_P = 128, NBLK_S = 33;
constexpr float NEGF = -1e30f;

constexpr size_t O_YP = 0;
constexpr size_t O_YS = O_YP + (size_t)NP * DM;
constexpr size_t O_KCP = O_YS + (size_t)DEC * DM;
constexpr size_t O_VCP = O_KCP + (size_t)NP * 128;
constexpr size_t O_KSP = O_VCP + (size_t)NP * 128;
constexpr size_t O_VSP = O_KSP + (size_t)NP * 128;
constexpr size_t O_KWP = O_VSP + (size_t)NP * 128;
constexpr size_t O_VWP = O_KWP + (size_t)NB * 512 * 128;
constexpr size_t O_KCS = O_VWP + (size_t)NB * 512 * 128;
constexpr size_t O_VCS = O_KCS + (size_t)DEC * 128;
constexpr size_t O_KSS = O_VCS + (size_t)DEC * 128;
constexpr size_t O_VSS = O_KSS + (size_t)DEC * 128;
constexpr size_t O_KWS = O_VSS + (size_t)DEC * 128;
constexpr size_t O_VWS = O_KWS + (size_t)DEC * 512 * 128;
constexpr size_t O_VN = O_VWS + (size_t)DEC * 512 * 128;
constexpr size_t O_END = O_VN + (size_t)DEC * 512;

struct NaiveBufs {
  float* HN;
  float* Z;
  float* TAB;
  float* QR;
  float* KSR;
  float* KWR;
  float* VN;
  float* MIX;
  float* KCCP;
  float* VCCP;
  float* KCCS;
  float* VCCS;
  float* H;
};

struct Inputs {
  const float *x_p, *x_s, *ck_cmp, *cv_cmp, *ck_sel, *cv_sel, *ck_win, *cv_win;
  const int* pt;
  const float *norm_g, *w_in, *ln_g, *ln_b, *w_s, *b_s, *w_ck, *pe_ck, *w_cv, *pe_cv, *w_out, *final_g;
};

__device__ __forceinline__ float sigmoidf_(float x) { return 1.0f / (1.0f + expf(-x)); }
__device__ __forceinline__ float siluf_(float x) { return x / (1.0f + expf(-x)); }

__device__ __forceinline__ float block_sum256(float v, float* red) {
  for (int o = 32; o > 0; o >>= 1) v += __shfl_xor(v, o);
  __syncthreads();
  if ((threadIdx.x & 63) == 0) red[threadIdx.x >> 6] = v;
  __syncthreads();
  float r = red[0] + red[1] + red[2] + red[3];
  return r;
}

struct RopeInv { float v[8]; };
__global__ void n_rope_table(float* tab, RopeInv ri) {
  int idx = blockIdx.x * blockDim.x + threadIdx.x;
  if (idx >= 8192 * 8) return;
  int pos = idx >> 3, i = idx & 7;
  float inv = ri.v[0];
  if (i == 1) inv = ri.v[1]; if (i == 2) inv = ri.v[2]; if (i == 3) inv = ri.v[3]; if (i == 4) inv = ri.v[4];
  if (i == 5) inv = ri.v[5]; if (i == 6) inv = ri.v[6]; if (i == 7) inv = ri.v[7];
  float ang = (float)pos * inv;
  double x = (double)ang;
  double q = rint(x * 0.63661977236758134308);
  double r = fma(-q, 1.57079632679489655800, x);
  r = fma(-q, 6.12323399573676603587e-17, r);
  double r2 = r * r;
  double s = r * (1.0 + r2 * (-1.0 / 6 + r2 * (1.0 / 120 + r2 * (-1.0 / 5040 + r2 * (1.0 / 362880 + r2 * (-1.0 / 39916800 + r2 * (1.0 / 6227020800.0)))))));
  double c = 1.0 + r2 * (-0.5 + r2 * (1.0 / 24 + r2 * (-1.0 / 720 + r2 * (1.0 / 40320 + r2 * (-1.0 / 3628800 + r2 * (1.0 / 479001600.0 + r2 * (-1.0 / 87178291200.0)))))));
  long long qi = (long long)q;
  int qm = (int)(qi & 3);
  double sn, cs;
  if (qm == 0) { sn = s; cs = c; }
  else if (qm == 1) { sn = c; cs = -s; }
  else if (qm == 2) { sn = -s; cs = -c; }
  else { sn = -c; cs = s; }
  tab[pos * 16 + i] = (float)cs;
  tab[pos * 16 + 8 + i] = (float)sn;
}

__global__ __launch_bounds__(256) void n_rmsnorm_in(Inputs in, float* HN) {
  __shared__ float red[4];
  int row = blockIdx.x;
  const float* x = row < NP ? in.x_p + (size_t)row * DM : in.x_s + (size_t)(row - NP) * DM;
  float v[4]; float ss = 0.f;
  for (int j = 0; j < 4; ++j) { v[j] = x[threadIdx.x + 256 * j]; ss += v[j] * v[j]; }
  float tot = block_sum256(ss, red);
  float r = 1.0f / sqrtf(tot / DM + 1e-6f);
  for (int j = 0; j < 4; ++j) HN[(size_t)row * DM + threadIdx.x + 256 * j] = v[j] * r * in.norm_g[threadIdx.x + 256 * j];
}

__global__ __launch_bounds__(256) void n_sgemm(const float* __restrict__ A, const float* __restrict__ B, float* __restrict__ C, int M, int N, int K) {
  __shared__ float As[16][128 + 4];
  __shared__ float Bs[16][128];
  const int tid = threadIdx.x, tx = tid & 15, ty = tid >> 4;
  const int m0 = blockIdx.y * 128, n0 = blockIdx.x * 128;
  float acc[8][8];
  for (int i = 0; i < 8; ++i) for (int j = 0; j < 8; ++j) acc[i][j] = 0.f;
  for (int k0 = 0; k0 < K; k0 += 16) {
    for (int i = 0; i < 2; ++i) {
      int r = (tid >> 2) + 64 * i, c4 = (tid & 3) * 4;
      float4 a = *(const float4*)(A + (size_t)(m0 + r) * K + k0 + c4);
      As[c4 + 0][r] = a.x; As[c4 + 1][r] = a.y; As[c4 + 2][r] = a.z; As[c4 + 3][r] = a.w;
    }
    for (int i = 0; i < 2; ++i) {
      int r = (tid >> 5) + 8 * i, c = (tid & 31) * 4;
      float4 b = make_float4(0.f, 0.f, 0.f, 0.f);
      if (n0 + c < N) b = *(const float4*)(B + (size_t)(k0 + r) * N + n0 + c);
      *(float4*)&Bs[r][c] = b;
    }
    __syncthreads();
#pragma unroll
    for (int k = 0; k < 16; ++k) {
      float a[8], b[8];
#pragma unroll
      for (int i = 0; i < 8; ++i) a[i] = As[k][ty * 8 + i];
#pragma unroll
      for (int j = 0; j < 8; ++j) b[j] = Bs[k][tx * 8 + j];
#pragma unroll
      for (int i = 0; i < 8; ++i)
#pragma unroll
        for (int j = 0; j < 8; ++j) acc[i][j] = fmaf(a[i], b[j], acc[i][j]);
    }
    __syncthreads();
  }
  for (int i = 0; i < 8; ++i) {
    int r = m0 + ty * 8 + i;
    for (int j = 0; j < 8; j += 4) {
      int c = n0 + tx * 8 + j;
      if (c < N) *(float4*)(C + (size_t)r * N + c) = make_float4(acc[i][j], acc[i][j + 1], acc[i][j + 2], acc[i][j + 3]);
    }
  }
}

__global__ void n_post(NaiveBufs nb, float* out) {
  size_t idx = (size_t)blockIdx.x * blockDim.x + threadIdx.x;
  if (idx >= (size_t)NR * 1280) return;
  int row = (int)(idx / 1280), col = C_Q + (int)(idx % 1280);
  const float* z = nb.Z + (size_t)row * DIN;
  int pos = row < NP ? (row % SEQ) : PAST;
  int b = row < NP ? row / SEQ : row - NP;
  float v = z[col];
  int d = (col - C_Q) & 63;
  bool roped = (col < C_KC) || (col >= C_KS && col < C_VS) || (col >= C_KW && col < C_VW);
  if (roped && d < 16) {
    int i = d & 7;
    float cs = nb.TAB[pos * 16 + i], sn = nb.TAB[pos * 16 + 8 + i];
    if (d < 8) { float x2 = z[col + 8]; v = v * cs - x2 * sn; }
    else { float x1 = z[col - 8]; v = v * cs + x1 * sn; }
  }
  if (col < C_KC) { nb.QR[(size_t)row * 512 + (col - C_Q)] = v; return; }
  int sec = (col - C_KC) / 128, cc = (col - C_KC) % 128;
  if (sec == 2) nb.KSR[(size_t)row * 128 + cc] = v;
  if (sec == 4) nb.KWR[(size_t)row * 128 + cc] = v;
  if (sec < 4) {
    if (row < NP) out[O_KCP + (size_t)sec * NP * 128 + (size_t)row * 128 + cc] = v;
    else out[O_KCS + (size_t)sec * DEC * 128 + (size_t)(row - NP) * 128 + cc] = v;
  } else {
    int w = sec - 4;
    if (row < NP) {
      if (pos >= SEQ - 512) out[O_KWP + (size_t)w * NB * 512 * 128 + ((size_t)b * 512 + (pos - (SEQ - 512))) * 128 + cc] = v;
    } else {
      out[O_KWS + (size_t)w * DEC * 512 * 128 + ((size_t)b * 512 + 511) * 128 + cc] = v;
    }
  }
}

__global__ void n_winroll(Inputs in, float* out) {
  size_t idx = (size_t)blockIdx.x * blockDim.x + threadIdx.x;
  if (idx >= (size_t)2 * DEC * 511 * 128) return;
  int w = (int)(idx / ((size_t)DEC * 511 * 128));
  size_t r = idx % ((size_t)DEC * 511 * 128);
  int b = (int)(r / (511 * 128)); int rem = (int)(r % (511 * 128)); int j = rem / 128, c = rem % 128;
  const float* src = w ? in.cv_win : in.ck_win;
  out[O_KWS + (size_t)w * DEC * 512 * 128 + ((size_t)b * 512 + j) * 128 + c] = src[((size_t)b * 512 + j + 1) * 128 + c];
}

__global__ __launch_bounds__(256) void n_ln_v(Inputs in, NaiveBufs nb, float* out) {
  __shared__ float red[4];
  int row = blockIdx.x;
  const float* z = nb.Z + (size_t)row * DIN + C_V;
  float v0 = z[threadIdx.x], v1 = z[threadIdx.x + 256];
  float mean = block_sum256(v0 + v1, red) / 512.f;
  float d0 = v0 - mean, d1 = v1 - mean;
  float var = block_sum256(d0 * d0 + d1 * d1, red) / 512.f;
  float r = 1.0f / sqrtf(var + 1e-6f);
  float y0 = d0 * r * in.ln_g[threadIdx.x] + in.ln_b[threadIdx.x];
  float y1 = d1 * r * in.ln_g[threadIdx.x + 256] + in.ln_b[threadIdx.x + 256];
  nb.VN[(size_t)row * 512 + threadIdx.x] = y0; nb.VN[(size_t)row * 512 + threadIdx.x + 256] = y1;
  if (row >= NP) { out[O_VN + (size_t)(row - NP) * 512 + threadIdx.x] = y0; out[O_VN + (size_t)(row - NP) * 512 + threadIdx.x + 256] = y1; }
}

__global__ __launch_bounds__(512) void n_gmlp(Inputs in, NaiveBufs nb) {
  int row = blockIdx.x, c = threadIdx.x;
  int g = c >> 6;
  int local = row < NP ? (row % 128) : 0;
  const float* w = in.w_s + ((size_t)g * 128 + local) * 128;
  float s = in.b_s[g * 128 + local];
  const float* vn = nb.VN + (size_t)(row - local) * 512 + c;
  for (int j = 0; j <= local; ++j) s = fmaf(w[j], vn[(size_t)j * 512], s);
  const float* z = nb.Z + (size_t)row * DIN;
  nb.MIX[(size_t)row * DM + c] = z[C_U + c] * s * siluf_(z[C_ZA + c]);
}

__global__ __launch_bounds__(64) void n_compress(Inputs in, NaiveBufs nb, int which) {
  int e = threadIdx.x;
  int bid = blockIdx.x;
  const int NPB = NB * NCMP_P * 2;
  const float* W = which ? in.w_cv : in.w_ck;
  const float* PE = which ? in.pe_cv : in.pe_ck;
  float acc = 0.f;
  if (bid < NPB) {
    int b = bid / (NCMP_P * 2), rem = bid % (NCMP_P * 2), n = rem >> 1, h = rem & 1;
    const float* zb = nb.Z + (size_t)(b * SEQ + 16 * n) * DIN + (which ? C_VC : C_KC) + h * 64;
    for (int l = 0; l < 32; ++l)
      for (int d = 0; d < 64; ++d) acc = fmaf(zb[(size_t)l * DIN + d] + PE[l * 64 + d], W[(l * 64 + d) * 64 + e], acc);
    float* dst = (which ? nb.VCCP : nb.KCCP) + (size_t)bid * 64;
    if (!which && e < 16) {
      float other = __shfl_xor(acc, 8);
      int i = e & 7; int pos = 16 * n;
      float cs = nb.TAB[pos * 16 + i], sn = nb.TAB[pos * 16 + 8 + i];
      acc = e < 8 ? acc * cs - other * sn : acc * cs + other * sn;
    }
    dst[e] = acc;
  } else {
    bid -= NPB;
    int b = bid / (NCMP_S * 2), rem = bid % (NCMP_S * 2), n = rem >> 1, h = rem & 1;
    const float* cache = which ? in.cv_cmp : in.ck_cmp;
    for (int l = 0; l < 32; ++l) {
      int p = 16 * n + l;
      int page = in.pt[b * NPAGES + (p >> 7)];
      const float* tk = cache + ((size_t)page * PAGE + (p & 127)) * 128 + h * 64;
      for (int d = 0; d < 64; ++d) acc = fmaf(tk[d] + PE[l * 64 + d], W[(l * 64 + d) * 64 + e], acc);
    }
    float* dst = (which ? nb.VCCS : nb.KCCS) + (size_t)bid * 64;
    if (!which && e < 16) {
      float other = __shfl_xor(acc, 8);
      int i = e & 7; int pos = 16 * n;
      float cs = nb.TAB[pos * 16 + i], sn = nb.TAB[pos * 16 + 8 + i];
      acc = e < 8 ? acc * cs - other * sn : acc * cs + other * sn;
    }
    dst[e] = acc;
  }
}

__device__ __forceinline__ float wave_max(float v) { for (int o = 32; o > 0; o >>= 1) v = fmaxf(v, __shfl_xor(v, o)); return v; }
__device__ __forceinline__ float wave_sum(float v) { for (int o = 32; o > 0; o >>= 1) v += __shfl_xor(v, o); return v; }

__device__ __forceinline__ void softmax4(float* sc, int stride, int n) {
  int wave = threadIdx.x >> 6, lane = threadIdx.x & 63;
  float* s = sc + wave * stride;
  float m = NEGF;
  for (int i = lane; i < n; i += 64) m = fmaxf(m, s[i]);
  m = wave_max(m);
  float sum = 0.f;
  for (int i = lane; i < n; i += 64) { float v = s[i]; float e = v > -1e29f ? expf(v - m) : 0.f; s[i] = e; sum += e; }
  sum = wave_sum(sum);
  float inv = sum > 0.f ? 1.0f / sum : 0.f;
  for (int i = lane; i < n; i += 64) s[i] *= inv;
}

__global__ __launch_bounds__(256) void n_attn(Inputs in, NaiveBufs nb) {
  __shared__ float qs[4][64];
  __shared__ float sc[4][1024];
  __shared__ float impv[128];
  __shared__ int sel[16];
  __shared__ float oacc[3][4][64];
  const int tid = threadIdx.x;
  const int row = blockIdx.x >> 1, h = blockIdx.x & 1;
  const bool isp = row < NP;
  const int b = isp ? row / SEQ : row - NP;
  const int t = isp ? row % SEQ : PAST;
  const int ncmp = isp ? NCMP_P : NCMP_S, nblk = isp ? NBLK_P : NBLK_S;
  { int g = tid >> 6, d = tid & 63; qs[g][d] = nb.QR[(size_t)row * 512 + (h * 4 + g) * 64 + d]; }
  __syncthreads();
  const float* kcc = isp ? nb.KCCP + (size_t)b * NCMP_P * 128 : nb.KCCS + (size_t)b * NCMP_S * 128;
  const float* vcc = isp ? nb.VCCP + (size_t)b * NCMP_P * 128 : nb.VCCS + (size_t)b * NCMP_S * 128;
  for (int idx = tid; idx < 4 * ncmp; idx += 256) {
    int g = idx / ncmp, n = idx % ncmp;
    float s = NEGF;
    if (16 * n + 31 <= t) {
      const float* k = kcc + (size_t)n * 128 + h * 64; float a = 0.f;
      for (int d = 0; d < 64; ++d) a = fmaf(qs[g][d], k[d], a);
      s = a * 0.125f;
    }
    sc[g][n] = s;
  }
  __syncthreads();
  softmax4(&sc[0][0], 1024, ncmp);
  __syncthreads();
  { int g = tid >> 6, d = tid & 63; float a = 0.f;
    for (int n = 0; n < ncmp; ++n) a = fmaf(sc[g][n], vcc[(size_t)n * 128 + h * 64 + d], a);
    oacc[0][g][d] = a; }
  if (tid < nblk) {
    int k = tid; float im = 0.f;
    for (int n = 4 * k - 1; n <= 4 * k + 3; ++n) if (n >= 0 && n < ncmp) im += sc[0][n] + sc[1][n] + sc[2][n] + sc[3][n];
    int cur = t >> 6;
    bool forced = (k == 0) || (k == cur) || (k == cur - 1);
    bool valid = 64 * k <= t;
    impv[k] = valid ? (forced ? im + 1e4f : im) : -INFINITY;
  }
  __syncthreads();
  if (tid == 0) {
    unsigned long long used0 = 0ull, used1 = 0ull;
    for (int j = 0; j < 16; ++j) {
      int best = -1; float bv = 0.f;
      for (int k = 0; k < nblk; ++k) {
        bool u = k < 64 ? ((used0 >> k) & 1ull) : ((used1 >> (k - 64)) & 1ull);
        if (u) continue;
        float v = impv[k];
        if (best < 0 || v > bv) { best = k; bv = v; }
      }
      sel[j] = best;
      if (best < 64) used0 |= 1ull << best; else used1 |= 1ull << (best - 64);
    }
  }
  __syncthreads();
  for (int idx = tid; idx < 1024; idx += 256) {
    int j = idx >> 6, kk = idx & 63;
    int tok = sel[j] * 64 + kk;
    float s4[4] = {NEGF, NEGF, NEGF, NEGF};
    if (tok <= t) {
      const float* k;
      if (isp) k = nb.KSR + (size_t)(b * SEQ + tok) * 128 + h * 64;
      else if (tok < PAST) k = in.ck_sel + ((size_t)in.pt[b * NPAGES + (tok >> 7)] * PAGE + (tok & 127)) * 128 + h * 64;
      else k = nb.KSR + (size_t)row * 128 + h * 64;
      float a0 = 0.f, a1 = 0.f, a2 = 0.f, a3 = 0.f;
      for (int d = 0; d < 64; ++d) { float kv = k[d]; a0 = fmaf(qs[0][d], kv, a0); a1 = fmaf(qs[1][d], kv, a1); a2 = fmaf(qs[2][d], kv, a2); a3 = fmaf(qs[3][d], kv, a3); }
      s4[0] = a0 * 0.125f; s4[1] = a1 * 0.125f; s4[2] = a2 * 0.125f; s4[3] = a3 * 0.125f;
    }
    for (int g = 0; g < 4; ++g) sc[g][idx] = s4[g];
  }
  __syncthreads();
  softmax4(&sc[0][0], 1024, 1024);
  __syncthreads();
  { int g = tid >> 6, d = tid & 63; float a = 0.f;
    for (int idx = 0; idx < 1024; ++idx) {
      float p = sc[g][idx];
      if (p != 0.f) {
        int tok = sel[idx >> 6] * 64 + (idx & 63);
        const float* v;
        if (isp) v = nb.Z + (size_t)(b * SEQ + tok) * DIN + C_VS + h * 64;
        else if (tok < PAST) v = in.cv_sel + ((size_t)in.pt[b * NPAGES + (tok >> 7)] * PAGE + (tok & 127)) * 128 + h * 64;
        else v = nb.Z + (size_t)row * DIN + C_VS + h * 64;
        a = fmaf(p, v[d], a);
      }
    }
    oacc[1][g][d] = a; }
  __syncthreads();
  for (int idx = tid; idx < 512; idx += 256) {
    int kp = t - 511 + idx;
    float s4[4] = {NEGF, NEGF, NEGF, NEGF};
    if (kp >= 0) {
      const float* k;
      if (isp) k = nb.KWR + (size_t)(b * SEQ + kp) * 128 + h * 64;
      else if (idx < 511) k = in.ck_win + ((size_t)b * 512 + idx + 1) * 128 + h * 64;
      else k = nb.KWR + (size_t)row * 128 + h * 64;
      float a0 = 0.f, a1 = 0.f, a2 = 0.f, a3 = 0.f;
      for (int d = 0; d < 64; ++d) { float kv = k[d]; a0 = fmaf(qs[0][d], kv, a0); a1 = fmaf(qs[1][d], kv, a1); a2 = fmaf(qs[2][d], kv, a2); a3 = fmaf(qs[3][d], kv, a3); }
      s4[0] = a0 * 0.125f; s4[1] = a1 * 0.125f; s4[2] = a2 * 0.125f; s4[3] = a3 * 0.125f;
    }
    for (int g = 0; g < 4; ++g) sc[g][idx] = s4[g];
  }
  __syncthreads();
  softmax4(&sc[0][0], 1024, 512);
  __syncthreads();
  { int g = tid >> 6, d = tid & 63; float a = 0.f;
    for (int idx = 0; idx < 512; ++idx) {
      float p = sc[g][idx];
      if (p != 0.f) {
        int kp = t - 511 + idx;
        const float* v;
        if (isp) v = nb.Z + (size_t)(b * SEQ + kp) * DIN + C_VW + h * 64;
        else if (idx < 511) v = in.cv_win + ((size_t)b * 512 + idx + 1) * 128 + h * 64;
        else v = nb.Z + (size_t)row * DIN + C_VW + h * 64;
        a = fmaf(p, v[d], a);
      }
    }
    oacc[2][g][d] = a; }
  __syncthreads();
  { int g = tid >> 6, d = tid & 63; int hq = h * 4 + g;
    const float* z = nb.Z + (size_t)row * DIN;
    float g0 = sigmoidf_(z[C_G + hq * 3 + 0]), g1 = sigmoidf_(z[C_G + hq * 3 + 1]), g2 = sigmoidf_(z[C_G + hq * 3 + 2]);
    float o = g0 * oacc[0][g][d] + g1 * oacc[1][g][d] + g2 * oacc[2][g][d];
    nb.MIX[(size_t)row * DM + 512 + hq * 64 + d] = o * siluf_(z[C_ZB + hq * 64 + d]); }
}

__global__ __launch_bounds__(256) void n_final(Inputs in, NaiveBufs nb, float* out) {
  __shared__ float red[4];
  int row = blockIdx.x;
  const float* x = row < NP ? in.x_p + (size_t)row * DM : in.x_s + (size_t)(row - NP) * DM;
  float* y = row < NP ? out + O_YP + (size_t)row * DM : out + O_YS + (size_t)(row - NP) * DM;
  float v[4]; float ss = 0.f;
  for (int j = 0; j < 4; ++j) { v[j] = x[threadIdx.x + 256 * j] + nb.H[(size_t)row * DM + threadIdx.x + 256 * j]; ss += v[j] * v[j]; }
  float tot = block_sum256(ss, red);
  float r = 1.0f / sqrtf(tot / DM + 1e-6f);
  for (int j = 0; j < 4; ++j) y[threadIdx.x + 256 * j] = v[j] * r * in.final_g[threadIdx.x + 256 * j];
}

extern "C" void kernel_launch(void* const* d_in, const int* in_sizes, int n_in,
                              void* d_out, int out_size, void* d_ws, size_t ws_size,
                              hipStream_t stream) {
  Inputs in;
  in.x_p = (const float*)d_in[0]; in.x_s = (const float*)d_in[1];
  in.ck_cmp = (const float*)d_in[2]; in.cv_cmp = (const float*)d_in[3]; in.ck_sel = (const float*)d_in[4]; in.cv_sel = (const float*)d_in[5];
  in.ck_win = (const float*)d_in[6]; in.cv_win = (const float*)d_in[7]; in.pt = (const int*)d_in[8];
  in.norm_g = (const float*)d_in[9]; in.w_in = (const float*)d_in[10]; in.ln_g = (const float*)d_in[11]; in.ln_b = (const float*)d_in[12];
  in.w_s = (const float*)d_in[13]; in.b_s = (const float*)d_in[14]; in.w_ck = (const float*)d_in[15]; in.pe_ck = (const float*)d_in[16];
  in.w_cv = (const float*)d_in[17]; in.pe_cv = (const float*)d_in[18]; in.w_out = (const float*)d_in[19]; in.final_g = (const float*)d_in[20];
  float* out = (float*)d_out;
  char* ws = (char*)d_ws;
  size_t off = 0;
  auto take = [&](size_t bytes) { char* p = ws + off; off += (bytes + 255) & ~(size_t)255; return p; };
  NaiveBufs nb;
  nb.HN = (float*)take((size_t)NR * DM * 4);
  nb.Z = (float*)take((size_t)NR * DIN * 4);
  nb.TAB = (float*)take((size_t)8192 * 16 * 4);
  nb.QR = (float*)take((size_t)NR * 512 * 4);
  nb.KSR = (float*)take((size_t)NR * 128 * 4);
  nb.KWR = (float*)take((size_t)NR * 128 * 4);
  nb.VN = (float*)take((size_t)NR * 512 * 4);
  nb.MIX = (float*)take((size_t)NR * DM * 4);
  nb.KCCP = (float*)take((size_t)NB * NCMP_P * 128 * 4);
  nb.VCCP = (float*)take((size_t)NB * NCMP_P * 128 * 4);
  nb.KCCS = (float*)take((size_t)DEC * NCMP_S * 128 * 4);
  nb.VCCS = (float*)take((size_t)DEC * NCMP_S * 128 * 4);
  nb.H = (float*)take((size_t)NR * DM * 4);

  if (off > ws_size) return;
  RopeInv ri;
  for (int i = 0; i < 8; ++i) ri.v[i] = (float)pow(500000.0, -(double)i / 8.0);
  n_rope_table<<<(8192 * 8 + 255) / 256, 256, 0, stream>>>(nb.TAB, ri);
  n_rmsnorm_in<<<NR, 256, 0, stream>>>(in, nb.HN);
  n_sgemm<<<dim3((DIN + 127) / 128, NR / 128), 256, 0, stream>>>(nb.HN, in.w_in, nb.Z, NR, DIN, DM);
  n_post<<<(unsigned)(((size_t)NR * 1280 + 255) / 256), 256, 0, stream>>>(nb, out);
  n_winroll<<<(unsigned)(((size_t)2 * DEC * 511 * 128 + 255) / 256), 256, 0, stream>>>(in, out);
  n_ln_v<<<NR, 256, 0, stream>>>(in, nb, out);
  n_gmlp<<<NR, 512, 0, stream>>>(in, nb);
  n_compress<<<NB * NCMP_P * 2 + DEC * NCMP_S * 2, 64, 0, stream>>>(in, nb, 0);
  n_compress<<<NB * NCMP_P * 2 + DEC * NCMP_S * 2, 64, 0, stream>>>(in, nb, 1);
  n_attn<<<NR * 2, 256, 0, stream>>>(in, nb);
  n_sgemm<<<dim3(DM / 128, NR / 128), 256, 0, stream>>>(nb.MIX, in.w_out, nb.H, NR, DM, DM);
  n_final<<<NR, 256, 0, stream>>>(in, nb, out);
}
```

```cpp
#include <hip/hip_runtime.h>
#include <hip/hip_cooperative_groups.h>
#include <stdint.h>
#include <cmath>
#include <cstdio>
namespace cg = cooperative_groups;

constexpr int DM_ = 1024, NB_ = 2, SEQ_ = 8192, NP_ = NB_ * SEQ_, DEC_ = 128, NR_ = NP_ + DEC_, NRP_ = 16640  ;
constexpr int PAST_ = 2048, PAGE_ = 128, NPAGES_ = 16;
constexpr int DIN_ = 3352, NPAD_ = 3584;
constexpr int NCMP_P = 511, NCMP_S = 127, NBLK_P = 128, NBLK_S = 33;
constexpr float NEGF = -1e30f;
constexpr float QSCALE_ = 0.125f * 1.4426950408889634f;

constexpr size_t OO_YP = 0;
constexpr size_t OO_YS = OO_YP + (size_t)NP_ * DM_;
constexpr size_t OO_KCP = OO_YS + (size_t)DEC_ * DM_;
constexpr size_t OO_VCP = OO_KCP + (size_t)NP_ * 128;
constexpr size_t OO_KSP = OO_VCP + (size_t)NP_ * 128;
constexpr size_t OO_VSP = OO_KSP + (size_t)NP_ * 128;
constexpr size_t OO_KWP = OO_VSP + (size_t)NP_ * 128;
constexpr size_t OO_VWP = OO_KWP + (size_t)NB_ * 512 * 128;
constexpr size_t OO_KCS = OO_VWP + (size_t)NB_ * 512 * 128;
constexpr size_t OO_VCS = OO_KCS + (size_t)DEC_ * 128;
constexpr size_t OO_KSS = OO_VCS + (size_t)DEC_ * 128;
constexpr size_t OO_VSS = OO_KSS + (size_t)DEC_ * 128;
constexpr size_t OO_KWS = OO_VSS + (size_t)DEC_ * 128;
constexpr size_t OO_VWS = OO_KWS + (size_t)DEC_ * 512 * 128;
constexpr size_t OO_VN = OO_VWS + (size_t)DEC_ * 512 * 128;
constexpr size_t OO_END = OO_VN + (size_t)DEC_ * 512;

#define LAS __attribute__((address_space(3)))
typedef unsigned short bf16_t;
typedef short bf16x8 __attribute__((ext_vector_type(8)));
typedef float f32x4 __attribute__((ext_vector_type(4)));
typedef float f32x16 __attribute__((ext_vector_type(16)));
typedef unsigned u32x4 __attribute__((ext_vector_type(4)));
typedef unsigned u32x2 __attribute__((ext_vector_type(2)));

struct Inputs {
  const float *x_p, *x_s, *ck_cmp, *cv_cmp, *ck_sel, *cv_sel, *ck_win, *cv_win;
  const int* pt;
  const float *norm_g, *w_in, *ln_g, *ln_b, *w_s, *b_s, *w_ck, *pe_ck, *w_cv, *pe_cv, *w_out, *final_g;
};

struct Bufs {
  float* TAB;
  bf16_t* WIN_T;
  bf16_t* WOUT_T;
  bf16_t* WS_T;
  bf16_t* WCK_T;
  bf16_t* WCV_T;
  float* BIASC;
  bf16_t* HN;
  bf16_t *U, *V, *ZA, *Q, *ZB;
  bf16_t *KS, *VS, *KW, *VW;
  float* GATES;
  float* GP;
  float* GS;
  bf16_t* MIX;
  float* H;
  float *KCCP, *VCCP, *KCCS, *VCCS;
};
struct RopeInv { float v[8]; };
struct Params { Inputs in; Bufs b; float* out; RopeInv ri; };

__device__ __forceinline__ float bf2f(unsigned short x) { return __uint_as_float(((unsigned)x) << 16); }
__device__ __forceinline__ unsigned f2bf(float f) { unsigned u = __float_as_uint(f); return (u + 0x7fffu + ((u >> 16) & 1u)) >> 16; }
__device__ __forceinline__ unsigned pk2(float lo, float hi) { return f2bf(lo) | (f2bf(hi) << 16); }
__device__ __forceinline__ float wave_sum(float v) {
#pragma unroll
  for (int o = 1; o < 64; o <<= 1) v += __shfl_xor(v, o);
  return v;
}
__device__ __forceinline__ float wave_max(float v) {
#pragma unroll
  for (int o = 1; o < 64; o <<= 1) v = fmaxf(v, __shfl_xor(v, o));
  return v;
}
__device__ __forceinline__ int crow(int r, int hi) { return (r & 3) + 8 * (r >> 2) + 4 * hi; }

namespace pg8 {
#define PG8_LAS __attribute__((address_space(3)))
typedef unsigned short bf16_t;
typedef short bf16x8 __attribute__((ext_vector_type(8)));
typedef float f32x4 __attribute__((ext_vector_type(4)));
typedef unsigned u32x4 __attribute__((ext_vector_type(4)));
constexpr int BM = 256, BK = 64, HALF = 128, HTB = HALF * BK * 2  , STAGE_BYTES = 8 * HTB, NXCD = 8, WGM = 8;

__host__ __device__ __forceinline__ int lds_byte(int r, int c) { const int st = (r >> 4) * 2 + (c >> 5), rr = r & 15, cc = c & 31, ob = rr * 64 + cc * 2; return st * 1024 + (ob ^ (((ob >> 9) & 1) << 5)); }
__host__ __device__ __forceinline__ void stage_rc(int b, int& R, int& C) { const int st = b / 1024, sb = b % 1024, swz = sb ^ (((sb >> 9) & 1) << 5); R = (st >> 1) * 16 + swz / 64; C = (st & 1) * 32 + (swz % 64) / 2; }
__host__ __device__ __forceinline__ int perm32(int rho) { const int n = rho >> 4, i = rho & 15; return 8 * (i >> 2) + 4 * n + (i & 3); }

struct Unit { int pm, pn; };
struct Gemm { const bf16_t* A; const bf16_t* Bt; int M, N, K; };

struct StaticOrder {
    int nM, nN, nwg, G, c;
    __host__ __device__ void init(int M, int N, int G_, int c_) { nM = M / BM; nN = N / BM; nwg = nM * nN; G = G_; c = c_; }
    __host__ __device__ bool next(int i, Unit& u) const {
        const long L = (long)i * G + c; if (L >= nwg) return false;
        int wgid = (int)L; { const int q = nwg / NXCD, r = nwg % NXCD, xcd = wgid % NXCD, off = wgid / NXCD; wgid = (xcd < r ? xcd * (q + 1) : r * (q + 1) + (xcd - r) * q) + off; }
        const int nig = WGM * nN, gid = wgid / nig, fm = gid * WGM, gsz = (nM - fm) < WGM ? (nM - fm) : WGM;
        u.pm = fm + ((wgid % nig) % gsz); u.pn = (wgid % nig) / gsz; return true;
    }
    __device__ __forceinline__ void a_ready(const Unit&) const {}
    __device__ __forceinline__ void done(const Unit&) const {}
};


__device__ __forceinline__ unsigned cvt_pk_bf16(float lo, float hi) { unsigned r; asm volatile("v_cvt_pk_bf16_f32 %0, %1, %2" : "=v"(r) : "v"(lo), "v"(hi)); return r; }
typedef float f32x2 __attribute__((ext_vector_type(2)));

__device__ __forceinline__ float bf2f(unsigned short x) { return __uint_as_float(((unsigned)x) << 16); }
__device__ __forceinline__ float silu_f(float x) { return x / (1.0f + __expf(-x)); }
__device__ __forceinline__ float sigm_f(float x) { return 1.0f / (1.0f + __expf(-x)); }

struct EpiInProj {
    static constexpr bool PERM = true, AFTER_DRAIN = false;
    bf16_t *U, *V, *ZA, *Q, *ZB, *KS, *VS, *KW, *VW; float* GATES; const float* TAB; float* out;
    __device__ __forceinline__ void store8(bf16_t* p, const float (&v)[8]) const {
        u32x4 w; w.x = cvt_pk_bf16(v[0], v[1]); w.y = cvt_pk_bf16(v[2], v[3]); w.z = cvt_pk_bf16(v[4], v[5]); w.w = cvt_pk_bf16(v[6], v[7]);
        *(u32x4*)p = w;
    }
    __device__ __forceinline__ void rope8(float (&v)[8], int pos, bool lo_half, bool active) const {
        float o[8];
#pragma unroll
        for (int j = 0; j < 8; ++j) o[j] = __shfl_xor(v[j], 16);
        if (active) {
            const f32x4 c0 = *(const f32x4*)(TAB + pos * 16), c1 = *(const f32x4*)(TAB + pos * 16 + 4);
            const f32x4 s0 = *(const f32x4*)(TAB + pos * 16 + 8), s1 = *(const f32x4*)(TAB + pos * 16 + 12);
            const float cs[8] = {c0[0], c0[1], c0[2], c0[3], c1[0], c1[1], c1[2], c1[3]};
            const float sn[8] = {s0[0], s0[1], s0[2], s0[3], s1[0], s1[1], s1[2], s1[3]};
#pragma unroll
            for (int j = 0; j < 8; ++j) v[j] = lo_half ? (v[j] * cs[j] - o[j] * sn[j]) : (v[j] * cs[j] + o[j] * sn[j]);
        }
    }
    __device__ __forceinline__ void operator()(const f32x4 (&acc)[2][2][4][2], const Unit& u, int wr, int wc, int fr, int fq) const {
        const int pn = u.pn;
        const int d0 = (wc & 1) * 32 + 8 * fq;
        const bool rope_lane = ((wc & 1) == 0) && (fq < 2);
#pragma unroll
        for (int ai = 0; ai < 2; ++ai)
#pragma unroll
            for (int m = 0; m < 4; ++m) {
                const int row = u.pm * BM + ai * HALF + wr * 64 + m * 16 + fr;
                const int pos = row < NP_ ? (row & (SEQ_ - 1)) : PAST_;
#pragma unroll
                for (int bj = 0; bj < 2; ++bj) {
                    float v[8];
#pragma unroll
                    for (int j = 0; j < 4; ++j) { v[j] = acc[ai][bj][m][0][j]; v[4 + j] = acc[ai][bj][m][1][j]; }
                    const int cl = bj * HALF + wc * 32 + 8 * fq;
                    if (pn < 2) { store8(U + (size_t)row * 512 + pn * 256 + cl, v); }
                    else if (pn < 4) { store8(V + (size_t)row * 512 + (pn - 2) * 256 + cl, v); }
                    else if (pn < 6) {
#pragma unroll
                        for (int j = 0; j < 8; ++j) v[j] = silu_f(v[j]);
                        store8(ZA + (size_t)row * 512 + (pn - 4) * 256 + cl, v); }
                    else if (pn < 8) {
                        rope8(v, pos, fq == 0, rope_lane);
#pragma unroll
                        for (int j = 0; j < 8; ++j) v[j] *= QSCALE_;
                        store8(Q + (size_t)row * 512 + (pn - 6) * 256 + cl, v); }
                    else if (pn < 11) {
                        const int sec = (pn - 8) * 2 + bj;
                        const int cc = wc * 32 + 8 * fq;
                        if (sec == 2 || sec == 4) rope8(v, pos, fq == 0, rope_lane);
                        if (sec == 2) store8(KS + (size_t)row * 128 + cc, v);
                        if (sec == 3) store8(VS + (size_t)row * 128 + cc, v);
                        if (sec == 4) store8(KW + (size_t)row * 128 + cc, v);
                        if (sec == 5) store8(VW + (size_t)row * 128 + cc, v);
                        float* dst = nullptr;
                        if (sec < 4) {
                            if (row < NP_) dst = out + OO_KCP + (size_t)sec * NP_ * 128 + (size_t)row * 128 + cc;
                            else if (row < NR_) dst = out + OO_KCS + (size_t)sec * DEC_ * 128 + (size_t)(row - NP_) * 128 + cc;
                        } else {
                            const int w = sec - 4;
                            if (row < NP_) { if (pos >= SEQ_ - 512) dst = out + OO_KWP + (size_t)w * 2 * 512 * 128 + ((size_t)(row >> 13) * 512 + (pos - (SEQ_ - 512))) * 128 + cc; }
                            else if (row < NR_) dst = out + OO_KWS + (size_t)w * DEC_ * 512 * 128 + ((size_t)(row - NP_) * 512 + 511) * 128 + cc;
                        }
                        if (dst) { *(f32x4*)dst = (f32x4){v[0], v[1], v[2], v[3]}; *(f32x4*)(dst + 4) = (f32x4){v[4], v[5], v[6], v[7]}; }
                    }
                    else if (pn < 13) {
#pragma unroll
                        for (int j = 0; j < 8; ++j) v[j] = silu_f(v[j]);
                        store8(ZB + (size_t)row * 512 + (pn - 11) * 256 + cl, v); }
                    else {
                        if (cl < 24) {
#pragma unroll
                            for (int j = 0; j < 8; ++j) v[j] = sigm_f(v[j]);
                            float* g = GATES + (size_t)row * 32 + cl;
                            *(f32x4*)g = (f32x4){v[0], v[1], v[2], v[3]}; *(f32x4*)(g + 4) = (f32x4){v[4], v[5], v[6], v[7]};
                        }
                    }
                }
            }
    }
};

struct EpiOutProj {
    static constexpr bool PERM = true, AFTER_DRAIN = false;
    const float* xp; const float* xs; float* H;
    __device__ __forceinline__ void operator()(const f32x4 (&acc)[2][2][4][2], const Unit& u, int wr, int wc, int fr, int fq) const {
#pragma unroll
        for (int ai = 0; ai < 2; ++ai)
#pragma unroll
            for (int m = 0; m < 4; ++m) {
                const int row = u.pm * BM + ai * HALF + wr * 64 + m * 16 + fr;
                if (row < NR_) {
                    const float* x = row < NP_ ? xp + (size_t)row * 1024 : xs + (size_t)(row - NP_) * 1024;
#pragma unroll
                    for (int bj = 0; bj < 2; ++bj) {
                        const int c = u.pn * BM + bj * HALF + wc * 32 + 8 * fq;
                        const f32x4 x0 = *(const f32x4*)(x + c), x1 = *(const f32x4*)(x + c + 4);
                        *(f32x4*)(H + (size_t)row * 1024 + c) = x0 + acc[ai][bj][m][0];
                        *(f32x4*)(H + (size_t)row * 1024 + c + 4) = x1 + acc[ai][bj][m][1];
                    }
                }
            }
    }
};

template <class Epi, class Sched, bool ALIGN_EPI = false, bool SP2 = false>
__device__ __forceinline__ void gemm_phase(PG8_LAS unsigned char* lds, const Gemm g, const Sched& S, const Epi& E) {
    const int tid = threadIdx.x, wid = __builtin_amdgcn_readfirstlane(tid >> 6), lane = tid & 63, wr = wid >> 2, wc = wid & 3, fr = lane & 15, fq = lane >> 4;
    const int K = g.K, nt = K / BK;
    unsigned voffA[2], voffB[2];
#pragma unroll
    for (int i = 0; i < 2; ++i) { int R, C; stage_rc(tid * 16 + i * 8192, R, C); const int Rb = Epi::PERM ? ((R & ~31) + perm32(R & 31)) : R;
        voffA[i] = (unsigned)(R * K + C) * 2u; voffB[i] = (unsigned)(Rb * K + C) * 2u; }
    const size_t kstep = (size_t)(BK * 2);
    const size_t hstep = (size_t)HALF * K * 2;
    const size_t tstep = 2 * hstep;
    const unsigned ldsw = (unsigned)wid * 1024u;
    const int aoff = lds_byte(wr * 64 + fr, fq * 8), boff = lds_byte(wc * 32 + fr, fq * 8);
#define PG8_SA(b, h) (((b) * 2 + (h)) * HTB)
#define PG8_SB(b, h) ((4 + (b) * 2 + (h)) * HTB)
#define PG8_STAGE(bufoff, gbase, voff) do { _Pragma("unroll") for (int _i = 0; _i < 2; ++_i) \
        __builtin_amdgcn_global_load_lds((const unsigned*)((const char*)(gbase) + (voff)[_i]), (PG8_LAS unsigned*)(lds + (bufoff) + ldsw + _i * 8192), 16, 0, 0); } while (0)
#define PG8_LDA(dst, b, h) do { _Pragma("unroll") for (int m = 0; m < 4; ++m) _Pragma("unroll") for (int k = 0; k < 2; ++k) dst[m][k] = *(const PG8_LAS bf16x8*)(lds + PG8_SA(b, h) + aoff + m * 2048 + k * 1024); } while (0)
#define PG8_LDB(dst, b, h) do { _Pragma("unroll") for (int n = 0; n < 2; ++n) _Pragma("unroll") for (int k = 0; k < 2; ++k) dst[n][k] = *(const PG8_LAS bf16x8*)(lds + PG8_SB(b, h) + boff + n * 2048 + k * 1024); } while (0)
#define PG8_MMA(ai, bj, At, Bt) do { __builtin_amdgcn_s_setprio(1); _Pragma("unroll") for (int m = 0; m < 4; ++m) _Pragma("unroll") for (int n = 0; n < 2; ++n) _Pragma("unroll") for (int k = 0; k < 2; ++k) \
        acc[ai][bj][m][n] = __builtin_amdgcn_mfma_f32_16x16x32_bf16(Bt[n][k], At[m][k], acc[ai][bj][m][n], 0, 0, 0); __builtin_amdgcn_s_setprio(0); } while (0)
#define PG8_WAIT_V(n) asm volatile("s_waitcnt vmcnt(" #n ")" ::: "memory")
#define PG8_WAIT_L(n) asm volatile("s_waitcnt lgkmcnt(" #n ")" ::: "memory")
#define PG8_BAR __builtin_amdgcn_s_barrier()
#define PG8_SCHED __builtin_amdgcn_sched_barrier(0)
    Unit cur, nxt; int ui = 0;
    if (!S.next(0, cur)) return;
    f32x4 acc[2][2][4][2];
#pragma unroll
    for (int a = 0; a < 2; ++a)
#pragma unroll
        for (int b = 0; b < 2; ++b)
#pragma unroll
            for (int m = 0; m < 4; ++m)
#pragma unroll
                for (int n = 0; n < 2; ++n) acc[a][b][m][n] = (f32x4){0.f, 0.f, 0.f, 0.f};
    bf16x8 At[4][2], B0[2][2], B1[2][2];
    const char* cA = (const char*)g.A + (size_t)cur.pm * tstep; const char* cB = (const char*)g.Bt + (size_t)cur.pn * tstep;
    S.a_ready(cur);
    if constexpr (SP2) {
        PG8_STAGE(PG8_SB(0, 0), cB, voffB); PG8_STAGE(PG8_SB(0, 1), cB + hstep, voffB); PG8_STAGE(PG8_SA(0, 0), cA, voffA); PG8_STAGE(PG8_SA(0, 1), cA + hstep, voffA);
        if (wr == 1) PG8_BAR;
        PG8_WAIT_V(2); PG8_BAR;
        PG8_STAGE(PG8_SB(1, 0), cB + kstep, voffB); PG8_STAGE(PG8_SA(1, 0), cA + kstep, voffA); PG8_STAGE(PG8_SB(1, 1), cB + hstep + kstep, voffB);
        PG8_WAIT_V(6); PG8_BAR;
    } else {
        PG8_STAGE(PG8_SB(0, 0), cB, voffB); PG8_STAGE(PG8_SA(0, 0), cA, voffA); PG8_STAGE(PG8_SB(0, 1), cB + hstep, voffB); PG8_STAGE(PG8_SA(0, 1), cA + hstep, voffA);
        if (wr == 1) PG8_BAR;
        PG8_WAIT_V(4); PG8_BAR;
        PG8_STAGE(PG8_SB(1, 0), cB + kstep, voffB); PG8_STAGE(PG8_SA(1, 0), cA + kstep, voffA); PG8_STAGE(PG8_SB(1, 1), cB + hstep + kstep, voffB);
        PG8_WAIT_V(6); PG8_BAR;
    }
    for (;;) {
        const bool has_next = S.next(ui + 1, nxt);
        const char* nA = has_next ? (const char*)g.A + (size_t)nxt.pm * tstep : cA; const char* nB = has_next ? (const char*)g.Bt + (size_t)nxt.pn * tstep : cB;
        for (int t = 0; t < nt; t += 2) {
            const bool last = (t == nt - 2);
            const char* a1 = cA + (size_t)(t + 1) * kstep;
            const char* a2 = last ? nA : cA + (size_t)(t + 2) * kstep; const char* b2 = last ? nB : cB + (size_t)(t + 2) * kstep;
            const char* a3 = a2 + kstep; const char* b3 = b2 + kstep;
            if (last && has_next) S.a_ready(nxt);
            if constexpr (SP2) {
            PG8_LDB(B0, 0, 0); PG8_LDB(B1, 0, 1); PG8_SCHED; PG8_LDA(At, 0, 0); PG8_STAGE(PG8_SA(1, 1), a1 + hstep, voffA);
            PG8_WAIT_V(8); PG8_WAIT_L(0); PG8_BAR; PG8_MMA(0, 0, At, B0); PG8_MMA(0, 1, At, B1); PG8_BAR; PG8_SCHED;
            PG8_LDA(At, 0, 1); PG8_STAGE(PG8_SB(0, 0), b2, voffB); PG8_STAGE(PG8_SB(0, 1), b2 + hstep, voffB); PG8_STAGE(PG8_SA(0, 0), a2, voffA);
            PG8_WAIT_V(8); PG8_WAIT_L(0); PG8_BAR; PG8_MMA(1, 0, At, B0); PG8_MMA(1, 1, At, B1); PG8_BAR; PG8_SCHED;
            PG8_LDB(B0, 1, 0); PG8_LDB(B1, 1, 1); PG8_SCHED; PG8_LDA(At, 1, 0); PG8_STAGE(PG8_SA(0, 1), a2 + hstep, voffA);
            PG8_WAIT_V(8); PG8_WAIT_L(0); PG8_BAR; PG8_MMA(0, 0, At, B0); PG8_MMA(0, 1, At, B1); PG8_BAR; PG8_SCHED;
            PG8_LDA(At, 1, 1); PG8_STAGE(PG8_SB(1, 0), b3, voffB); PG8_STAGE(PG8_SB(1, 1), b3 + hstep, voffB); PG8_STAGE(PG8_SA(1, 0), a3, voffA);
            PG8_WAIT_V(8); PG8_WAIT_L(0); PG8_BAR; PG8_MMA(1, 0, At, B0); PG8_MMA(1, 1, At, B1); PG8_BAR; PG8_SCHED;
            } else {
            PG8_LDB(B0, 0, 0); PG8_SCHED; PG8_LDA(At, 0, 0); PG8_STAGE(PG8_SA(1, 1), a1 + hstep, voffA);
            PG8_WAIT_L(8); PG8_BAR; PG8_WAIT_L(0); PG8_MMA(0, 0, At, B0); PG8_BAR; PG8_SCHED;
            PG8_LDB(B1, 0, 1); PG8_STAGE(PG8_SB(0, 0), b2, voffB);
            PG8_BAR; PG8_WAIT_L(0); PG8_MMA(0, 1, At, B1); PG8_BAR;
            PG8_LDA(At, 0, 1); PG8_STAGE(PG8_SA(0, 0), a2, voffA);
            PG8_BAR; PG8_WAIT_L(0); PG8_MMA(1, 0, At, B0); PG8_BAR; PG8_SCHED;
            PG8_STAGE(PG8_SB(0, 1), b2 + hstep, voffB);
            PG8_WAIT_V(6); PG8_BAR; PG8_MMA(1, 1, At, B1); PG8_BAR;
            PG8_LDB(B0, 1, 0); PG8_SCHED; PG8_LDA(At, 1, 0); PG8_STAGE(PG8_SA(0, 1), a2 + hstep, voffA);
            PG8_WAIT_L(8); PG8_BAR; PG8_WAIT_L(0); PG8_MMA(0, 0, At, B0); PG8_BAR; PG8_SCHED;
            PG8_LDB(B1, 1, 1); PG8_STAGE(PG8_SB(1, 0), b3, voffB);
            PG8_BAR; PG8_WAIT_L(0); PG8_MMA(0, 1, At, B1); PG8_BAR;
            PG8_LDA(At, 1, 1); PG8_STAGE(PG8_SA(1, 0), a3, voffA);
            PG8_BAR; PG8_WAIT_L(0); PG8_MMA(1, 0, At, B0); PG8_BAR; PG8_SCHED;
            PG8_STAGE(PG8_SB(1, 1), b3 + hstep, voffB);
            PG8_WAIT_V(6); PG8_BAR; PG8_MMA(1, 1, At, B1); PG8_BAR;
            }
        }
        if constexpr (ALIGN_EPI) { if (wr == 0) PG8_BAR; }
        if constexpr (!Epi::AFTER_DRAIN) { E(acc, cur, wr, wc, fr, fq); S.done(cur); }
        if (!has_next) break;
#pragma unroll
        for (int a = 0; a < 2; ++a)
#pragma unroll
            for (int b = 0; b < 2; ++b)
#pragma unroll
                for (int m = 0; m < 4; ++m)
#pragma unroll
                    for (int n = 0; n < 2; ++n) acc[a][b][m][n] = (f32x4){0.f, 0.f, 0.f, 0.f};
        cur = nxt; cA = nA; cB = nB; ++ui;
        if constexpr (ALIGN_EPI) { if (wr == 1) PG8_BAR; }
    }
    PG8_WAIT_V(0);
    if constexpr (!ALIGN_EPI) { if (wr == 0) PG8_BAR; }
    PG8_BAR;
    if constexpr (Epi::AFTER_DRAIN) { E.fused(acc, cur, wr, wc, fr, fq, lds, wid, lane); S.done(cur); }
#undef PG8_SA
#undef PG8_SB
#undef PG8_STAGE
#undef PG8_LDA
#undef PG8_LDB
#undef PG8_MMA
#undef PG8_WAIT_V
#undef PG8_WAIT_L
#undef PG8_BAR
#undef PG8_SCHED
}
}

__device__ __forceinline__ int win_srccol(int n) { return n < 2816 ? n : (n < 3328 ? n + 24 : (n < 3352 ? n - 3328 + 2816 : -1)); }

template <bool REMAP>
__device__ __forceinline__ void p0_transpose_item(const float* W, int Nsrc, int K, bf16_t* WT, int nblk, LAS float* scr, int item, int lane) {
  const int kb = item / nblk, nb = item % nblk, k0 = 64 * kb, n0 = 32 * nb;
  const int nd = n0 + (lane & 31);
  const int sc = REMAP ? win_srccol(nd) : nd;
#pragma unroll 8
  for (int i = 0; i < 32; ++i) { const int kk = 2 * i + (lane >> 5); scr[kk * 33 + (lane & 31)] = sc >= 0 ? W[(size_t)(k0 + kk) * Nsrc + sc] : 0.f; }
  asm volatile("s_waitcnt lgkmcnt(0)" ::: "memory");
  const int c = lane & 7;
#pragma unroll
  for (int j = 0; j < 4; ++j) { const int n = (lane >> 3) + 8 * j; const LAS float* s = scr + (8 * c) * 33 + n;
    u32x4 o; o.x = pk2(s[0 * 33], s[1 * 33]); o.y = pk2(s[2 * 33], s[3 * 33]); o.z = pk2(s[4 * 33], s[5 * 33]); o.w = pk2(s[6 * 33], s[7 * 33]);
    *(u32x4*)(WT + (size_t)(n0 + n) * K + k0 + 8 * c) = o; }
  asm volatile("s_waitcnt lgkmcnt(0)" ::: "memory");
}

__device__ __forceinline__ void rope_entry(float* tab, int idx, const RopeInv& ri) {
  const int pos = idx >> 3, i = idx & 7;
  float inv = ri.v[0];
  if (i == 1) inv = ri.v[1]; if (i == 2) inv = ri.v[2]; if (i == 3) inv = ri.v[3]; if (i == 4) inv = ri.v[4];
  if (i == 5) inv = ri.v[5]; if (i == 6) inv = ri.v[6]; if (i == 7) inv = ri.v[7];
  const float ang = (float)pos * inv;
  const double x = (double)ang;
  const double q = rint(x * 0.63661977236758134308);
  double r = fma(-q, 1.57079632679489655800, x);
  r = fma(-q, 6.12323399573676603587e-17, r);
  const double r2 = r * r;
  const double s = r * (1.0 + r2 * (-1.0 / 6 + r2 * (1.0 / 120 + r2 * (-1.0 / 5040 + r2 * (1.0 / 362880 + r2 * (-1.0 / 39916800 + r2 * (1.0 / 6227020800.0)))))));
  const double c = 1.0 + r2 * (-0.5 + r2 * (1.0 / 24 + r2 * (-1.0 / 720 + r2 * (1.0 / 40320 + r2 * (-1.0 / 3628800 + r2 * (1.0 / 479001600.0 + r2 * (-1.0 / 87178291200.0)))))));
  const int qm = (int)((long long)q & 3);
  double sn, cs;
  if (qm == 0) { sn = s; cs = c; } else if (qm == 1) { sn = c; cs = -s; } else if (qm == 2) { sn = -s; cs = -c; } else { sn = -c; cs = s; }
  tab[pos * 16 + i] = (float)cs; tab[pos * 16 + 8 + i] = (float)sn;
}

__device__ __forceinline__ void phase0(const Params& P, LAS unsigned char* lds) {
  const int tid = threadIdx.x, lane = tid & 63, wave = tid >> 6;
  const int gw = blockIdx.x * 8 + wave, NGW = gridDim.x * 8;
  const int gt = blockIdx.x * 512 + tid, NGT = gridDim.x * 512;
  LAS float* scr = (LAS float*)(lds + wave * 16384);
  constexpr int I_IN = (1024 / 64) * (NPAD_ / 32), I_OUT = (1024 / 64) * (1024 / 32);
  for (int it = gw; it < I_IN + I_OUT; it += NGW) {
    if (it < I_IN) p0_transpose_item<true>(P.in.w_in, DIN_, 1024, P.b.WIN_T, NPAD_ / 32, scr, it, lane);
    else p0_transpose_item<false>(P.in.w_out, 1024, 1024, P.b.WOUT_T, 1024 / 32, scr, it - I_IN, lane);
  }
  for (int i = gt; i < 8192 * 8; i += NGT) rope_entry(P.b.TAB, i, P.ri);
  for (int i = gt; i < 8 * 128 * 128; i += NGT) { const int t = (i >> 7) & 127, s = i & 127; P.b.WS_T[i] = (bf16_t)f2bf(s <= t ? P.in.w_s[i] : 0.f); }
  for (int x = gt; x < 2 * 16 * 128 * 64; x += NGT) {
    const int which = x >> 17, y = x & 131071; const int d = y & 63, n = (y >> 6) & 127, i = y >> 13; const int j = n >> 6, e = n & 63;
    const float* w = which ? P.in.w_cv : P.in.w_ck;
    (which ? P.b.WCV_T : P.b.WCK_T)[y] = (bf16_t)f2bf(w[((16 * j + i) * 64 + d) * 64 + e]);
  }
  if (blockIdx.x == 0) {
    LAS float* red = (LAS float*)(lds + 8 * 16384);
    const int which = tid >> 8, part = (tid >> 6) & 3, e = tid & 63;
    const float* w = which ? P.in.w_cv : P.in.w_ck; const float* pe = which ? P.in.pe_cv : P.in.pe_ck;
    float a = 0.f;
    for (int ld = part * 512; ld < part * 512 + 512; ++ld) a = fmaf(pe[ld], w[ld * 64 + e], a);
    red[tid] = a;
    __syncthreads();
    if (part == 0) P.b.BIASC[which * 64 + e] = red[which * 256 + e] + red[which * 256 + 64 + e] + red[which * 256 + 128 + e] + red[which * 256 + 192 + e];
  }
  for (int row = gw; row < NRP_; row += NGW) {
    u32x2* o = (u32x2*)(P.b.HN + (size_t)row * 1024) + lane;
    if (row >= NR_) {
#pragma unroll
      for (int j = 0; j < 4; ++j) o[64 * j] = (u32x2){0u, 0u};
      continue;
    }
    const float* x = row < NP_ ? P.in.x_p + (size_t)row * 1024 : P.in.x_s + (size_t)(row - NP_) * 1024;
    f32x4 v[4]; float ss = 0.f;
#pragma unroll
    for (int j = 0; j < 4; ++j) { v[j] = ((const f32x4*)x)[lane + 64 * j]; ss += (v[j][0] * v[j][0] + v[j][1] * v[j][1]) + (v[j][2] * v[j][2] + v[j][3] * v[j][3]); }
    const float r = 1.0f / sqrtf(wave_sum(ss) * (1.0f / 1024.f) + 1e-6f);
#pragma unroll
    for (int j = 0; j < 4; ++j) { const f32x4 g = ((const f32x4*)P.in.norm_g)[lane + 64 * j];
      o[64 * j] = (u32x2){pk2(v[j][0] * r * g[0], v[j][1] * r * g[1]), pk2(v[j][2] * r * g[2], v[j][3] * r * g[3])}; }
  }
}

#define MFMA32(a, b, c) __builtin_amdgcn_mfma_f32_32x32x16_bf16((a), (b), (c), 0, 0, 0)
constexpr int VNT_PITCH = 136;
__device__ __forceinline__ void gmlp_prompt_item(const Params& P, LAS unsigned char* lds, int item) {
  const int tid = threadIdx.x, lane = tid & 63, wave = tid >> 6, r = lane & 31, h = lane >> 5;
  const int r0 = item * 128;
  LAS float* stats = (LAS float*)lds;
  LAS bf16_t* vnT = (LAS bf16_t*)(lds + 1024);
  for (int rr = 0; rr < 16; ++rr) {
    const int row = r0 + wave * 16 + rr;
    const u32x4 raw = *(const u32x4*)(P.b.V + (size_t)row * 512 + lane * 8);
    float v[8];
#pragma unroll
    for (int j = 0; j < 4; ++j) { v[2 * j] = __uint_as_float(raw[j] << 16); v[2 * j + 1] = __uint_as_float(raw[j] & 0xffff0000u); }
    float s = 0.f;
#pragma unroll
    for (int j = 0; j < 8; ++j) s += v[j];
    const float mean = wave_sum(s) * (1.0f / 512.f);
    float q = 0.f;
#pragma unroll
    for (int j = 0; j < 8; ++j) { const float d = v[j] - mean; q += d * d; }
    const float rstd = 1.0f / sqrtf(wave_sum(q) * (1.0f / 512.f) + 1e-6f);
    if (lane == 0) { stats[(wave * 16 + rr) * 2] = mean; stats[(wave * 16 + rr) * 2 + 1] = rstd; }
  }
  __syncthreads();
  const int g = wave;
  {
    const float lg = P.in.ln_g[g * 64 + lane], lb = P.in.ln_b[g * 64 + lane];
#pragma unroll 8
    for (int s = 0; s < 128; ++s) {
      const float v = bf2f(P.b.V[(size_t)(r0 + s) * 512 + g * 64 + lane]);
      const float vn = (v - stats[2 * s]) * stats[2 * s + 1] * lg + lb;
      vnT[(g * 64 + lane) * VNT_PITCH + s] = (bf16_t)f2bf(vn);
    }
  }
  asm volatile("s_waitcnt lgkmcnt(0)" ::: "memory");
  const bf16_t* Wg = P.b.WS_T + (size_t)g * 128 * 128;
#pragma unroll 1
  for (int ti = 0; ti < 4; ++ti) {
    f32x16 acc[2];
#pragma unroll
    for (int ci = 0; ci < 2; ++ci)
#pragma unroll
      for (int i = 0; i < 16; ++i) acc[ci][i] = 0.f;
#pragma unroll 2
    for (int ks = 0; ks < 2 * ti + 2; ++ks) {
      const bf16x8 a = *(const bf16x8*)(Wg + (size_t)(32 * ti + r) * 128 + 16 * ks + 8 * h);
#pragma unroll
      for (int ci = 0; ci < 2; ++ci) {
        const bf16x8 b = *(const LAS bf16x8*)(vnT + (g * 64 + 32 * ci + r) * VNT_PITCH + 16 * ks + 8 * h);
        acc[ci] = MFMA32(a, b, acc[ci]);
      }
    }
#pragma unroll
    for (int ci = 0; ci < 2; ++ci)
#pragma unroll
      for (int i = 0; i < 16; ++i) {
        const int t = 32 * ti + crow(i, h), c = g * 64 + 32 * ci + r; const size_t row = (size_t)(r0 + t);
        const float sres = acc[ci][i] + P.in.b_s[g * 128 + t];
        const float o = bf2f(P.b.U[row * 512 + c]) * sres * bf2f(P.b.ZA[row * 512 + c]);
        P.b.MIX[row * 1024 + c] = (bf16_t)f2bf(o);
      }
  }
  __syncthreads();
}
__device__ __forceinline__ void gmlp_sample_item(const Params& P) {
  const int tid = threadIdx.x, lane = tid & 63, wave = tid >> 6;
  for (int rr = 0; rr < 16; ++rr) {
    const int sr = wave * 16 + rr; const size_t row = (size_t)(NP_ + sr);
    const u32x4 raw = *(const u32x4*)(P.b.V + row * 512 + lane * 8);
    float v[8];
#pragma unroll
    for (int j = 0; j < 4; ++j) { v[2 * j] = __uint_as_float(raw[j] << 16); v[2 * j + 1] = __uint_as_float(raw[j] & 0xffff0000u); }
    float s = 0.f;
#pragma unroll
    for (int j = 0; j < 8; ++j) s += v[j];
    const float mean = wave_sum(s) * (1.0f / 512.f);
    float q = 0.f;
#pragma unroll
    for (int j = 0; j < 8; ++j) { const float d = v[j] - mean; q += d * d; }
    const float rstd = 1.0f / sqrtf(wave_sum(q) * (1.0f / 512.f) + 1e-6f);
    const int g = lane >> 3;
    const float w0 = P.in.w_s[(size_t)g * 128 * 128], b0 = P.in.b_s[g * 128];
    const u32x4 ur = *(const u32x4*)(P.b.U + row * 512 + lane * 8), zr = *(const u32x4*)(P.b.ZA + row * 512 + lane * 8);
    float vn[8], o[8];
#pragma unroll
    for (int j = 0; j < 8; ++j) vn[j] = (v[j] - mean) * rstd * P.in.ln_g[lane * 8 + j] + P.in.ln_b[lane * 8 + j];
#pragma unroll
    for (int j = 0; j < 4; ++j) {
      o[2 * j] = __uint_as_float(ur[j] << 16) * (w0 * vn[2 * j] + b0) * __uint_as_float(zr[j] << 16);
      o[2 * j + 1] = __uint_as_float(ur[j] & 0xffff0000u) * (w0 * vn[2 * j + 1] + b0) * __uint_as_float(zr[j] & 0xffff0000u);
    }
    float* vo = P.out + OO_VN + (size_t)sr * 512 + lane * 8;
    *(f32x4*)vo = (f32x4){vn[0], vn[1], vn[2], vn[3]}; *(f32x4*)(vo + 4) = (f32x4){vn[4], vn[5], vn[6], vn[7]};
    *(u32x4*)(P.b.MIX + row * 1024 + lane * 8) = (u32x4){pk2(o[0], o[1]), pk2(o[2], o[3]), pk2(o[4], o[5]), pk2(o[6], o[7])};
  }
}

__device__ __forceinline__ void phase5(const Params& P) {
  const int tid = threadIdx.x, lane = tid & 63, wave = tid >> 6;
  const int gw = blockIdx.x * 8 + wave, NGW = gridDim.x * 8;
  for (int row = gw; row < NR_; row += NGW) {
    const f32x4* hrow = (const f32x4*)(P.b.H + (size_t)row * 1024);
    f32x4 v[4]; float ss = 0.f;
#pragma unroll
    for (int j = 0; j < 4; ++j) { v[j] = hrow[lane + 64 * j]; ss += (v[j][0] * v[j][0] + v[j][1] * v[j][1]) + (v[j][2] * v[j][2] + v[j][3] * v[j][3]); }
    const float r = 1.0f / sqrtf(wave_sum(ss) * (1.0f / 1024.f) + 1e-6f);
    f32x4* y = (f32x4*)(row < NP_ ? P.out + OO_YP + (size_t)row * 1024 : P.out + OO_YS + (size_t)(row - NP_) * 1024);
#pragma unroll
    for (int j = 0; j < 4; ++j) { const f32x4 g = ((const f32x4*)P.in.final_g)[lane + 64 * j]; y[lane + 64 * j] = v[j] * r * g; }
  }
}

constexpr int CA_PITCH = 72;
__device__ __forceinline__ void compress_item(const Params& P, LAS unsigned char* lds, int it) {
  const int tid = threadIdx.x, lane = tid & 63, wave = tid >> 6, r = lane & 31, hh = lane >> 5;
  const int wm = wave >> 1, wn = wave & 1;
  int which, h; const float* src; float* G;
  const int m = tid >> 2, q4 = tid & 3;
  if (it < 32) {
    which = it & 1; const int qtr = (it >> 1) & 3; h = (it >> 3) & 1; const int b = it >> 4;
    src = P.out + (which ? OO_VCP : OO_KCP) + ((size_t)(b * SEQ_ + 16 * (qtr * 128 + m)) * 128 + h * 64 + q4 * 16);
    G = P.b.GP + ((size_t)(((b * 2 + h) * 2 + which) * 512 + qtr * 128)) * 128;
  } else {
    const int j = it - 32; which = j & 1; h = (j >> 1) & 1; const int b = j >> 2;
    const int page = P.in.pt[b * NPAGES_ + (m >> 3)];
    src = (which ? P.in.cv_cmp : P.in.ck_cmp) + ((size_t)(page * PAGE_ + 16 * (m & 7)) * 128 + h * 64 + q4 * 16);
    G = P.b.GS + ((size_t)(((b * 2 + h) * 2 + which) * 128)) * 128;
  }
  const bf16_t* WT = which ? P.b.WCV_T : P.b.WCK_T;
  LAS bf16_t* A0 = (LAS bf16_t*)lds;
  f32x4 ld[4];
#pragma unroll
  for (int j = 0; j < 4; ++j) ld[j] = *(const f32x4*)(src + 4 * j);
  f32x16 acc[2];
#pragma unroll
  for (int nt = 0; nt < 2; ++nt)
#pragma unroll
    for (int i = 0; i < 16; ++i) acc[nt][i] = 0.f;
  {
    LAS u32x4* dst = (LAS u32x4*)(A0 + m * CA_PITCH + q4 * 16);
    dst[0] = (u32x4){pk2(ld[0][0], ld[0][1]), pk2(ld[0][2], ld[0][3]), pk2(ld[1][0], ld[1][1]), pk2(ld[1][2], ld[1][3])};
    dst[1] = (u32x4){pk2(ld[2][0], ld[2][1]), pk2(ld[2][2], ld[2][3]), pk2(ld[3][0], ld[3][1]), pk2(ld[3][2], ld[3][3])};
  }
  __syncthreads();
#pragma unroll 1
  for (int i = 0; i < 16; ++i) {
    if (i + 1 < 16) {
#pragma unroll
      for (int j = 0; j < 4; ++j) ld[j] = *(const f32x4*)(src + (size_t)(i + 1) * 128 + 4 * j);
    }
    LAS bf16_t* Ab = A0 + (i & 1) * 128 * CA_PITCH;
#pragma unroll
    for (int kk = 0; kk < 4; ++kk) {
      const bf16x8 a = *(const LAS bf16x8*)(Ab + (32 * wm + r) * CA_PITCH + 16 * kk + 8 * hh);
#pragma unroll
      for (int nt = 0; nt < 2; ++nt) {
        const bf16x8 bb = *(const bf16x8*)(WT + ((size_t)(i * 128 + 64 * wn + 32 * nt + r)) * 64 + 16 * kk + 8 * hh);
        acc[nt] = MFMA32(a, bb, acc[nt]);
      }
    }
    if (i + 1 < 16) {
      LAS u32x4* dst = (LAS u32x4*)(A0 + ((i + 1) & 1) * 128 * CA_PITCH + m * CA_PITCH + q4 * 16);
      dst[0] = (u32x4){pk2(ld[0][0], ld[0][1]), pk2(ld[0][2], ld[0][3]), pk2(ld[1][0], ld[1][1]), pk2(ld[1][2], ld[1][3])};
      dst[1] = (u32x4){pk2(ld[2][0], ld[2][1]), pk2(ld[2][2], ld[2][3]), pk2(ld[3][0], ld[3][1]), pk2(ld[3][2], ld[3][3])};
    }
    __syncthreads();
  }
#pragma unroll
  for (int nt = 0; nt < 2; ++nt)
#pragma unroll
    for (int i = 0; i < 16; ++i) G[(size_t)(32 * wm + crow(i, hh)) * 128 + 64 * wn + 32 * nt + r] = acc[nt][i];
}

__device__ __forceinline__ void winroll_phase(const Params& P) {
  const size_t NV = (size_t)2 * DEC_ * 511 * 32;
  for (size_t idx = (size_t)blockIdx.x * 512 + threadIdx.x; idx < NV; idx += (size_t)gridDim.x * 512) {
    const int w = (int)(idx / ((size_t)DEC_ * 511 * 32)); const size_t rr = idx % ((size_t)DEC_ * 511 * 32);
    const int b = (int)(rr / (511 * 32)); const int rem = (int)(rr % (511 * 32)); const int j = rem >> 5, c = rem & 31;
    const float* s = (w ? P.in.cv_win : P.in.ck_win) + ((size_t)b * 512 + j + 1) * 128 + c * 4;
    *(f32x4*)(P.out + OO_KWS + (size_t)w * DEC_ * 512 * 128 + ((size_t)b * 512 + j) * 128 + c * 4) = *(const f32x4*)s;
  }
}

constexpr int KT_PITCH = 72;
constexpr int AT_K = 0, AT_V = 9216, AT_IMP = 18432, AT_MASK = AT_IMP + 32768, AT_END = AT_MASK + 1024;

struct AttnState { float m, l; f32x16 o[2]; };

__device__ __forceinline__ void stage_kv(LAS unsigned char* lds, const bf16_t* Ksrc, const bf16_t* Vsrc, bool doV) {
  int tid = threadIdx.x; asm volatile("" : "+v"(tid));
  const int key = tid >> 3, ch = tid & 7;
  const u32x4 kraw = *(const u32x4*)(Ksrc + (size_t)key * 128 + ch * 8);
  *(LAS u32x4*)(lds + AT_K + (key * KT_PITCH + ch * 8) * 2) = kraw;
  if (doV) {
    const u32x4 vraw = *(const u32x4*)(Vsrc + (size_t)key * 128 + ch * 8);
    LAS bf16_t* vt = (LAS bf16_t*)(lds + AT_V);
#pragma unroll
    for (int j = 0; j < 4; ++j) { vt[(ch * 8 + 2 * j) * KT_PITCH + key] = (bf16_t)(vraw[j] & 0xffffu); vt[(ch * 8 + 2 * j + 1) * KT_PITCH + key] = (bf16_t)(vraw[j] >> 16); }
  }
}
__device__ __forceinline__ void stage_cmp(const Params& P, LAS unsigned char* lds, const float* Gk, const float* Gv, int n0, int nmax  , bool doV) {
  const int tid = threadIdx.x, key = tid >> 3, ch = tid & 7, n = n0 + key;
  float kv[8], vv[8];
#pragma unroll
  for (int j = 0; j < 8; ++j) { kv[j] = 0.f; vv[j] = 0.f; }
  if (n <= nmax) {
    const float* g0 = Gk + (size_t)n * 128 + ch * 8; const float* g1 = Gk + (size_t)(n + 1) * 128 + 64 + ch * 8;
#pragma unroll
    for (int j = 0; j < 8; ++j) kv[j] = g0[j] + g1[j] + P.b.BIASC[ch * 8 + j];
    if (ch < 2) {
      const int oc = ch ^ 1; float ov[8];
      const float* h0 = Gk + (size_t)n * 128 + oc * 8; const float* h1 = Gk + (size_t)(n + 1) * 128 + 64 + oc * 8;
#pragma unroll
      for (int j = 0; j < 8; ++j) ov[j] = h0[j] + h1[j] + P.b.BIASC[oc * 8 + j];
      const float* tb = P.b.TAB + (size_t)(16 * n) * 16;
#pragma unroll
      for (int j = 0; j < 8; ++j) kv[j] = ch == 0 ? kv[j] * tb[j] - ov[j] * tb[8 + j] : kv[j] * tb[j] + ov[j] * tb[8 + j];
    }
    if (doV) {
      const float* v0 = Gv + (size_t)n * 128 + ch * 8; const float* v1 = Gv + (size_t)(n + 1) * 128 + 64 + ch * 8;
#pragma unroll
      for (int j = 0; j < 8; ++j) vv[j] = v0[j] + v1[j] + P.b.BIASC[64 + ch * 8 + j];
    }
  }
  *(LAS u32x4*)(lds + AT_K + (key * KT_PITCH + ch * 8) * 2) = (u32x4){pk2(kv[0], kv[1]), pk2(kv[2], kv[3]), pk2(kv[4], kv[5]), pk2(kv[6], kv[7])};
  if (doV) {
    LAS bf16_t* vt = (LAS bf16_t*)(lds + AT_V);
#pragma unroll
    for (int j = 0; j < 8; ++j) vt[(ch * 8 + j) * KT_PITCH + key] = (bf16_t)f2bf(vv[j]);
  }
}

__device__ __forceinline__ void qk_tile(LAS unsigned char* lds, const bf16x8 (&qr)[4], f32x16& p0, f32x16& p1, int r, int hi) {
#pragma unroll
  for (int i = 0; i < 16; ++i) { p0[i] = 0.f; p1[i] = 0.f; }
#pragma unroll
  for (int s = 0; s < 4; ++s) {
    const bf16x8 k0 = *(const LAS bf16x8*)(lds + AT_K + ((r)*KT_PITCH + 16 * s + 8 * hi) * 2);
    const bf16x8 k1 = *(const LAS bf16x8*)(lds + AT_K + ((32 + r) * KT_PITCH + 16 * s + 8 * hi) * 2);
    p0 = MFMA32(k0, qr[s], p0); p1 = MFMA32(k1, qr[s], p1);
  }
}
__device__ __forceinline__ void pv_tile(LAS unsigned char* lds, const f32x16& p0, const f32x16& p1, f32x16 (&o)[2], int r, int hi) {
#pragma unroll
  for (int sp = 0; sp < 4; ++sp) {
    u32x4 pw;
#pragma unroll
    for (int j = 0; j < 4; ++j) pw[j] = sp < 2 ? pk2(p0[8 * sp + 2 * j], p0[8 * sp + 2 * j + 1]) : pk2(p1[8 * (sp - 2) + 2 * j], p1[8 * (sp - 2) + 2 * j + 1]);
    const bf16x8 pb = __builtin_bit_cast(bf16x8, pw);
#pragma unroll
    for (int dt = 0; dt < 2; ++dt) {
      const u32x2 a0 = *(const LAS u32x2*)(lds + AT_V + ((32 * dt + r) * KT_PITCH + 16 * sp + 4 * hi) * 2);
      const u32x2 a1 = *(const LAS u32x2*)(lds + AT_V + ((32 * dt + r) * KT_PITCH + 16 * sp + 8 + 4 * hi) * 2);
      const bf16x8 va = __builtin_bit_cast(bf16x8, (u32x4){a0[0], a0[1], a1[0], a1[1]});
      o[dt] = MFMA32(va, pb, o[dt]);
    }
  }
}

__device__ __forceinline__ void softmax_tile(AttnState& st, f32x16& p0, f32x16& p1, unsigned vm0, unsigned vm1) {
  float rm = NEGF;
#pragma unroll
  for (int i = 0; i < 16; ++i) { if ((vm0 >> i) & 1u) rm = fmaxf(rm, p0[i]); if ((vm1 >> i) & 1u) rm = fmaxf(rm, p1[i]); }
  rm = fmaxf(rm, __shfl_xor(rm, 32));
  const float mn = fmaxf(st.m, rm);
  const float alpha = __builtin_amdgcn_exp2f(st.m - mn);
  float ps = 0.f;
#pragma unroll
  for (int i = 0; i < 16; ++i) {
    p0[i] = ((vm0 >> i) & 1u) ? __builtin_amdgcn_exp2f(p0[i] - mn) : 0.f; p1[i] = ((vm1 >> i) & 1u) ? __builtin_amdgcn_exp2f(p1[i] - mn) : 0.f; ps += p0[i] + p1[i];
  }
  st.l = st.l * alpha + ps; st.m = mn;
#pragma unroll
  for (int dt = 0; dt < 2; ++dt)
#pragma unroll
    for (int i = 0; i < 16; ++i) st.o[dt][i] *= alpha;
}

__device__ __forceinline__ unsigned wave_max_u32(unsigned v) {
#pragma unroll
  for (int o = 1; o < 64; o <<= 1) { const unsigned t = (unsigned)__shfl_xor((int)v, o); v = t > v ? t : v; }
  return v;
}

__device__ __forceinline__ void attn_prompt_item(const Params& P, LAS unsigned char* lds, int it) {
  const int tid = threadIdx.x, lane = tid & 63, wave = tid >> 6, r = lane & 31, hi = lane >> 5;
  const int bh = it & 3, qt = 127 - (it >> 2); const int b = bh >> 1, h = bh & 1;
  const int t0 = qt * 64;
  const int tokl = 8 * wave + (r >> 2), g = r & 3, tok = t0 + tokl;
  const int rowi = b * SEQ_ + tok; const int hq = h * 4 + g;
#define row ((size_t)rowi)
  LAS float* IMP = (LAS float*)(lds + AT_IMP);
  LAS unsigned* MASK = (LAS unsigned*)(lds + AT_MASK);
  const size_t rowb = (size_t)b * SEQ_;
  for (int i = tid; i < 64 * 128; i += 512) IMP[i] = 0.f;
  bf16x8 qr[4];
#pragma unroll
  for (int s = 0; s < 4; ++s) qr[s] = *(const bf16x8*)(P.b.Q + row * 512 + hq * 64 + 16 * s + 8 * hi);
  f32x16 ot[2];
#pragma unroll
  for (int dt = 0; dt < 2; ++dt)
#pragma unroll
    for (int i = 0; i < 16; ++i) ot[dt][i] = 0.f;
  f32x16 p0, p1;

  const float* Gk = P.b.GP + (size_t)((b * 2 + h) * 2 + 0) * 512 * 128;
  const float* Gv = P.b.GP + (size_t)((b * 2 + h) * 2 + 1) * 512 * 128;
  const int tmax = t0 + 63;
  const int ncv = tmax >= 31 ? ((tmax - 31) >> 4) + 1 : 0;
  const int nct = (ncv + 63) >> 6;
  const int nlim = tok >= 31 ? ((tok - 31) >> 4) : -1;
  AttnState sc; sc.m = NEGF; sc.l = 0.f;
#pragma unroll
  for (int dt = 0; dt < 2; ++dt)
#pragma unroll
    for (int i = 0; i < 16; ++i) sc.o[dt][i] = 0.f;
#pragma unroll 1
  for (int ct = 0; ct < nct; ++ct) {
    __syncthreads();
    stage_cmp(P, lds, Gk, Gv, ct * 64, 510, false);
    __syncthreads();
    qk_tile(lds, qr, p0, p1, r, hi);
    unsigned vm0 = 0u, vm1 = 0u;
#pragma unroll
    for (int i = 0; i < 16; ++i) { const int n = ct * 64 + crow(i, hi); if (n <= nlim) vm0 |= 1u << i; if (n + 32 <= nlim) vm1 |= 1u << i; }
    softmax_tile(sc, p0, p1, vm0, vm1);
  }
  {
    const float lt = sc.l + __shfl_xor(sc.l, 32);
    const float inv = lt > 0.f ? 1.0f / lt : 0.f;
#pragma unroll 1
    for (int ct = 0; ct < nct; ++ct) {
      __syncthreads();
      stage_cmp(P, lds, Gk, Gv, ct * 64, 510, true);
      __syncthreads();
      qk_tile(lds, qr, p0, p1, r, hi);
#pragma unroll
      for (int i = 0; i < 16; ++i) {
        const int n = ct * 64 + crow(i, hi);
        p0[i] = n <= nlim ? __builtin_amdgcn_exp2f(p0[i] - sc.m) * inv : 0.f;
        p1[i] = n + 32 <= nlim ? __builtin_amdgcn_exp2f(p1[i] - sc.m) * inv : 0.f;
      }
      pv_tile(lds, p0, p1, sc.o, r, hi);
#pragma unroll
      for (int half = 0; half < 2; ++half)
#pragma unroll
        for (int a = 0; a < 4; ++a) {
          const f32x16& pp = half ? p1 : p0;
          float gs = (pp[4 * a] + pp[4 * a + 1]) + (pp[4 * a + 2] + pp[4 * a + 3]);
          float last = pp[4 * a + 3];
          gs += __shfl_xor(gs, 1); gs += __shfl_xor(gs, 2);
          last += __shfl_xor(last, 1); last += __shfl_xor(last, 2);
          const int k = ct * 16 + half * 8 + 2 * a + hi;
          if (g == 0) {
            __hip_atomic_fetch_add(IMP + tokl * 128 + k, gs, __ATOMIC_RELAXED, __HIP_MEMORY_SCOPE_WORKGROUP);
            if (k + 1 < 128) __hip_atomic_fetch_add(IMP + tokl * 128 + k + 1, last, __ATOMIC_RELAXED, __HIP_MEMORY_SCOPE_WORKGROUP);
          }
        }
    }
    const float g0 = P.b.GATES[row * 32 + hq * 3 + 0];
#pragma unroll
    for (int dt = 0; dt < 2; ++dt)
#pragma unroll
      for (int i = 0; i < 16; ++i) ot[dt][i] += g0 * sc.o[dt][i];
  }
  asm volatile("s_waitcnt lgkmcnt(0)" ::: "memory");
#pragma unroll 1
  for (int tk = 0; tk < 8; ++tk) {
    const int tl = 8 * wave + tk, tt = t0 + tl, cur = tt >> 6;
    bool s0, s1;
    if (cur < 16) { s0 = lane <= cur; s1 = false; }
    else {
      const int k0 = lane, k1 = lane + 64;
      const bool f0 = (k0 == 0) || (k0 == cur) || (k0 == cur - 1), f1 = (k1 == cur) || (k1 == cur - 1);
      const bool v0 = k0 <= cur, v1 = k1 <= cur;
      unsigned key0 = (v0 && !f0) ? ((__float_as_uint(IMP[tl * 128 + k0]) & 0xFFFFFF80u) + 0x80u + (unsigned)(127 - k0)) : 0u;
      unsigned key1 = (v1 && !f1) ? ((__float_as_uint(IMP[tl * 128 + k1]) & 0xFFFFFF80u) + 0x80u + (unsigned)(127 - k1)) : 0u;
      s0 = v0 && f0; s1 = v1 && f1;
#pragma unroll 1
      for (int itn = 0; itn < 13; ++itn) {
        const unsigned mx = wave_max_u32(key0 > key1 ? key0 : key1);
        if (mx == 0u) break;
        if (key0 == mx) { s0 = true; key0 = 0u; }
        if (key1 == mx) { s1 = true; key1 = 0u; }
      }
    }
    const unsigned long long b0 = __ballot(s0), b1 = __ballot(s1);
    if (lane == 0) { MASK[tl * 4 + 0] = (unsigned)b0; MASK[tl * 4 + 1] = (unsigned)(b0 >> 32); MASK[tl * 4 + 2] = (unsigned)b1; MASK[tl * 4 + 3] = (unsigned)(b1 >> 32); }
  }
  asm volatile("s_waitcnt lgkmcnt(0)" ::: "memory");

  {
    AttnState ss; ss.m = NEGF; ss.l = 0.f;
#pragma unroll
    for (int dt = 0; dt < 2; ++dt)
#pragma unroll
      for (int i = 0; i < 16; ++i) ss.o[dt][i] = 0.f;
#pragma unroll 1
    for (int k = 0; k <= qt; ++k) {
      __syncthreads();
      stage_kv(lds, P.b.KS + (rowb + (size_t)k * 64) * 128 + h * 64, P.b.VS + (rowb + (size_t)k * 64) * 128 + h * 64, true);
      __syncthreads();
      const unsigned w = MASK[tokl * 4 + (k >> 5)];
      const bool selb = (w >> (k & 31)) & 1u;
      if (__ballot(selb) != 0ull) {
        qk_tile(lds, qr, p0, p1, r, hi);
        unsigned vm0 = 0u, vm1 = 0u;
        if (selb) {
          if (k < qt) { vm0 = 0xffffu; vm1 = 0xffffu; }
          else {
#pragma unroll
            for (int i = 0; i < 16; ++i) { const int kp = k * 64 + crow(i, hi); if (kp <= tok) vm0 |= 1u << i; if (kp + 32 <= tok) vm1 |= 1u << i; }
          }
        }
        softmax_tile(ss, p0, p1, vm0, vm1);
        pv_tile(lds, p0, p1, ss.o, r, hi);
      }
    }
    const float lt = ss.l + __shfl_xor(ss.l, 32);
    const float gi = P.b.GATES[row * 32 + hq * 3 + 1] * (lt > 0.f ? 1.0f / lt : 0.f);
#pragma unroll
    for (int dt = 0; dt < 2; ++dt)
#pragma unroll
      for (int i = 0; i < 16; ++i) ot[dt][i] += gi * ss.o[dt][i];
  }
  {
    AttnState sw; sw.m = NEGF; sw.l = 0.f;
#pragma unroll
    for (int dt = 0; dt < 2; ++dt)
#pragma unroll
      for (int i = 0; i < 16; ++i) sw.o[dt][i] = 0.f;
    const int kfirst = qt >= 8 ? qt - 8 : 0;
#pragma unroll 1
    for (int k = kfirst; k <= qt; ++k) {
      __syncthreads();
      stage_kv(lds, P.b.KW + (rowb + (size_t)k * 64) * 128 + h * 64, P.b.VW + (rowb + (size_t)k * 64) * 128 + h * 64, true);
      __syncthreads();
      qk_tile(lds, qr, p0, p1, r, hi);
      unsigned vm0 = 0u, vm1 = 0u;
#pragma unroll
      for (int i = 0; i < 16; ++i) {
        const int kp = k * 64 + crow(i, hi);
        if (kp <= tok && kp > tok - 512) vm0 |= 1u << i;
        if (kp + 32 <= tok && kp + 32 > tok - 512) vm1 |= 1u << i;
      }
      softmax_tile(sw, p0, p1, vm0, vm1);
      pv_tile(lds, p0, p1, sw.o, r, hi);
    }
    const float lt = sw.l + __shfl_xor(sw.l, 32);
    const float gi = P.b.GATES[row * 32 + hq * 3 + 2] * (lt > 0.f ? 1.0f / lt : 0.f);
#pragma unroll
    for (int dt = 0; dt < 2; ++dt)
#pragma unroll
      for (int i = 0; i < 16; ++i) ot[dt][i] += gi * sw.o[dt][i];
  }
  int rowo = rowi; asm volatile("" : "+v"(rowo));
#pragma unroll
  for (int dt = 0; dt < 2; ++dt)
#pragma unroll
    for (int a = 0; a < 4; ++a) {
      const int d = 32 * dt + 8 * a + 4 * hi;
      const u32x2 zb = *(const u32x2*)(P.b.ZB + (size_t)rowo * 512 + hq * 64 + d);
      const float z0 = __uint_as_float(zb[0] << 16), z1 = __uint_as_float(zb[0] & 0xffff0000u), z2 = __uint_as_float(zb[1] << 16), z3 = __uint_as_float(zb[1] & 0xffff0000u);
      *(u32x2*)(P.b.MIX + (size_t)rowo * 1024 + 512 + hq * 64 + d) = (u32x2){pk2(ot[dt][4 * a] * z0, ot[dt][4 * a + 1] * z1), pk2(ot[dt][4 * a + 2] * z2, ot[dt][4 * a + 3] * z3)};
    }
  __syncthreads();
#undef row
}

__device__ __forceinline__ void softmax4_lds(LAS float* sc, int stride, int n) {
  const int wave = threadIdx.x >> 6, lane = threadIdx.x & 63;
  if (wave < 4) {
    LAS float* s = sc + wave * stride;
    float m = NEGF;
    for (int i = lane; i < n; i += 64) m = fmaxf(m, s[i]);
    m = wave_max(m);
    float sum = 0.f;
    for (int i = lane; i < n; i += 64) { const float v = s[i]; const float e = v > -1e29f ? exp2f(v - m) : 0.f; s[i] = e; sum += e; }
    sum = wave_sum(sum);
    const float inv = sum > 0.f ? 1.0f / sum : 0.f;
    for (int i = lane; i < n; i += 64) s[i] *= inv;
  }
}
__device__ __forceinline__ void attn_sample_item(const Params& P, LAS unsigned char* lds, int it) {
  const int tid = threadIdx.x;
  const int b = it >> 1, h = it & 1;
  const size_t row = (size_t)NP_ + b;
  const int t = PAST_;
  LAS float* qs = (LAS float*)lds;
  LAS float* sc = qs + 256;
  LAS float* impv = sc + 4096;
  LAS int* sel = (LAS int*)(impv + 64);
  LAS float* oacc = (LAS float*)(sel + 16);
  LAS float* kcc = oacc + 768;
  LAS float* vcc = kcc + 127 * 65 + 1;
  if (tid < 256) { const int g = tid >> 6, d = tid & 63; qs[g * 64 + d] = bf2f(P.b.Q[row * 512 + (h * 4 + g) * 64 + d]); }
  const float* Gk = P.b.GS + (size_t)((b * 2 + h) * 2 + 0) * 128 * 128;
  const float* Gv = P.b.GS + (size_t)((b * 2 + h) * 2 + 1) * 128 * 128;
  for (int idx = tid; idx < NCMP_S * 64; idx += 512) {
    const int n = idx >> 6, e = idx & 63;
    kcc[n * 65 + e] = Gk[(size_t)n * 128 + e] + Gk[(size_t)(n + 1) * 128 + 64 + e] + P.b.BIASC[e];
    vcc[n * 64 + e] = Gv[(size_t)n * 128 + e] + Gv[(size_t)(n + 1) * 128 + 64 + e] + P.b.BIASC[64 + e];
  }
  __syncthreads();
  for (int idx = tid; idx < NCMP_S * 8; idx += 512) {
    const int n = idx >> 3, i = idx & 7;
    const float x1 = kcc[n * 65 + i], x2 = kcc[n * 65 + 8 + i];
    const float cs = P.b.TAB[(size_t)(16 * n) * 16 + i], sn = P.b.TAB[(size_t)(16 * n) * 16 + 8 + i];
    kcc[n * 65 + i] = x1 * cs - x2 * sn; kcc[n * 65 + 8 + i] = x2 * cs + x1 * sn;
  }
  __syncthreads();
  for (int idx = tid; idx < 4 * NCMP_S; idx += 512) {
    const int g = idx / NCMP_S, n = idx % NCMP_S; float a = 0.f;
    for (int d = 0; d < 64; ++d) a = fmaf(qs[g * 64 + d], kcc[n * 65 + d], a);
    sc[g * 1024 + n] = a;
  }
  __syncthreads();
  softmax4_lds(sc, 1024, NCMP_S);
  __syncthreads();
  if (tid < 256) { const int g = tid >> 6, d = tid & 63; float a = 0.f;
    for (int n = 0; n < NCMP_S; ++n) a = fmaf(sc[g * 1024 + n], vcc[n * 64 + d], a);
    oacc[(0 * 4 + g) * 64 + d] = a; }
  if (tid < NBLK_S) {
    const int k = tid; float im = 0.f;
    for (int n = 4 * k - 1; n <= 4 * k + 3; ++n) if (n >= 0 && n < NCMP_S) im += sc[n] + sc[1024 + n] + sc[2048 + n] + sc[3072 + n];
    const int cur = t >> 6;
    const bool forced = (k == 0) || (k == cur) || (k == cur - 1);
    impv[k] = forced ? im + 1e4f : im;
  }
  __syncthreads();
  if (tid == 0) {
    unsigned long long used = 0ull;
    for (int j = 0; j < 16; ++j) {
      int best = -1; float bv = 0.f;
      for (int k = 0; k < NBLK_S; ++k) { if ((used >> k) & 1ull) continue; const float v = impv[k]; if (best < 0 || v > bv) { best = k; bv = v; } }
      sel[j] = best; used |= 1ull << best;
    }
  }
  __syncthreads();
  for (int idx = tid; idx < 1024; idx += 512) {
    const int j = idx >> 6, kk = idx & 63; const int tok = sel[j] * 64 + kk;
    float a0 = NEGF, a1 = NEGF, a2 = NEGF, a3 = NEGF;
    if (tok <= t) {
      a0 = a1 = a2 = a3 = 0.f;
      if (tok < PAST_) {
        const float* k = P.in.ck_sel + ((size_t)P.in.pt[b * NPAGES_ + (tok >> 7)] * PAGE_ + (tok & 127)) * 128 + h * 64;
        for (int d = 0; d < 64; d += 4) { const f32x4 kv = *(const f32x4*)(k + d);
#pragma unroll
          for (int c = 0; c < 4; ++c) { a0 = fmaf(qs[d + c], kv[c], a0); a1 = fmaf(qs[64 + d + c], kv[c], a1); a2 = fmaf(qs[128 + d + c], kv[c], a2); a3 = fmaf(qs[192 + d + c], kv[c], a3); } }
      } else {
        const float* k = P.out + OO_KSS + (size_t)b * 128 + h * 64;
        for (int d = 0; d < 64; ++d) { const float kv = k[d]; a0 = fmaf(qs[d], kv, a0); a1 = fmaf(qs[64 + d], kv, a1); a2 = fmaf(qs[128 + d], kv, a2); a3 = fmaf(qs[192 + d], kv, a3); }
      }
    }
    sc[idx] = a0; sc[1024 + idx] = a1; sc[2048 + idx] = a2; sc[3072 + idx] = a3;
  }
  __syncthreads();
  softmax4_lds(sc, 1024, 1024);
  __syncthreads();
  if (tid < 256) { const int g = tid >> 6, d = tid & 63; float a = 0.f;
    for (int idx = 0; idx < 1024; ++idx) {
      const float p = sc[g * 1024 + idx];
      if (p != 0.f) {
        const int tok = sel[idx >> 6] * 64 + (idx & 63);
        const float v = tok < PAST_ ? P.in.cv_sel[((size_t)P.in.pt[b * NPAGES_ + (tok >> 7)] * PAGE_ + (tok & 127)) * 128 + h * 64 + d]
                                    : P.out[OO_VSS + (size_t)b * 128 + h * 64 + d];
        a = fmaf(p, v, a);
      }
    }
    oacc[(1 * 4 + g) * 64 + d] = a; }
  __syncthreads();
  {
    const int idx = tid;
    float a0 = 0.f, a1 = 0.f, a2 = 0.f, a3 = 0.f;
    const float* k = idx < 511 ? P.in.ck_win + ((size_t)b * 512 + idx + 1) * 128 + h * 64 : P.out + OO_KWS + ((size_t)b * 512 + 511) * 128 + h * 64;
    for (int d = 0; d < 64; d += 4) { const f32x4 kv = *(const f32x4*)(k + d);
#pragma unroll
      for (int c = 0; c < 4; ++c) { a0 = fmaf(qs[d + c], kv[c], a0); a1 = fmaf(qs[64 + d + c], kv[c], a1); a2 = fmaf(qs[128 + d + c], kv[c], a2); a3 = fmaf(qs[192 + d + c], kv[c], a3); } }
    sc[idx] = a0; sc[1024 + idx] = a1; sc[2048 + idx] = a2; sc[3072 + idx] = a3;
  }
  __syncthreads();
  softmax4_lds(sc, 1024, 512);
  __syncthreads();
  if (tid < 256) { const int g = tid >> 6, d = tid & 63; float a = 0.f;
    for (int idx = 0; idx < 512; ++idx) {
      const float p = sc[g * 1024 + idx];
      const float v = idx < 511 ? P.in.cv_win[((size_t)b * 512 + idx + 1) * 128 + h * 64 + d] : P.out[OO_VWS + ((size_t)b * 512 + 511) * 128 + h * 64 + d];
      a = fmaf(p, v, a);
    }
    oacc[(2 * 4 + g) * 64 + d] = a; }
  __syncthreads();
  if (tid < 256) { const int g = tid >> 6, d = tid & 63; const int hq = h * 4 + g;
    const float* gt = P.b.GATES + row * 32 + hq * 3;
    const float o = gt[0] * oacc[(0 * 4 + g) * 64 + d] + gt[1] * oacc[(1 * 4 + g) * 64 + d] + gt[2] * oacc[(2 * 4 + g) * 64 + d];
    P.b.MIX[row * 1024 + 512 + hq * 64 + d] = (bf16_t)f2bf(o * bf2f(P.b.ZB[row * 512 + hq * 64 + d])); }
  __syncthreads();
}

constexpr int LDS_BYTES = 147456;
#define KLDS extern __shared__ __attribute__((aligned(16))) unsigned char lds_raw[]; LAS unsigned char* lds = (LAS unsigned char*)lds_raw;

__global__ void __launch_bounds__(512, 2) k_phase0(Params P) { KLDS phase0(P, lds); }
__global__ void __launch_bounds__(512, 2) k_gemm1(Params P) {
  KLDS
  pg8::Gemm g{P.b.HN, P.b.WIN_T, NRP_, NPAD_, 1024}; pg8::StaticOrder S; S.init(NRP_, NPAD_, (int)gridDim.x, (int)blockIdx.x);
  pg8::EpiInProj E{P.b.U, P.b.V, P.b.ZA, P.b.Q, P.b.ZB, P.b.KS, P.b.VS, P.b.KW, P.b.VW, P.b.GATES, P.b.TAB, P.out};
  pg8::gemm_phase<pg8::EpiInProj, pg8::StaticOrder, true, true>(lds, g, S, E);
}
__global__ void __launch_bounds__(512, 2) k_p2(Params P) {
  KLDS
  for (int item = blockIdx.x; item < 544 + 129; item += gridDim.x) {
    if (item < 544) compress_item(P, lds, item);
    else if (item < 544 + 128) gmlp_prompt_item(P, lds, item - 544);
    else gmlp_sample_item(P);
    __syncthreads();
  }
  winroll_phase(P);
}
__global__ void __launch_bounds__(512, 2) k_attn(Params P) {
  KLDS
  for (int item = blockIdx.x; item < 512; item += gridDim.x) attn_prompt_item(P, lds, item);
}
__global__ void __launch_bounds__(512, 2) k_attn_s(Params P) {
  KLDS
  for (int item = blockIdx.x; item < 256; item += gridDim.x) attn_sample_item(P, lds, item);
}
__global__ void __launch_bounds__(512, 2) k_gemm2(Params P) {
  KLDS
  pg8::Gemm g{P.b.MIX, P.b.WOUT_T, NRP_, 1024, 1024}; pg8::StaticOrder S; S.init(NRP_, 1024, (int)gridDim.x, (int)blockIdx.x);
  pg8::EpiOutProj E{P.in.x_p, P.in.x_s, P.b.H};
  pg8::gemm_phase<pg8::EpiOutProj, pg8::StaticOrder, true, true>(lds, g, S, E);
}
__global__ void __launch_bounds__(512, 2) k_final(Params P) { phase5(P); }

extern "C" void kernel_launch(void* const* d_in, const int* in_sizes, int n_in,
                              void* d_out, int out_size, void* d_ws, size_t ws_size,
                              hipStream_t stream) {
  Params P{};
  Inputs& in = P.in;
  in.x_p = (const float*)d_in[0]; in.x_s = (const float*)d_in[1];
  in.ck_cmp = (const float*)d_in[2]; in.cv_cmp = (const float*)d_in[3]; in.ck_sel = (const float*)d_in[4]; in.cv_sel = (const float*)d_in[5];
  in.ck_win = (const float*)d_in[6]; in.cv_win = (const float*)d_in[7]; in.pt = (const int*)d_in[8];
  in.norm_g = (const float*)d_in[9]; in.w_in = (const float*)d_in[10]; in.ln_g = (const float*)d_in[11]; in.ln_b = (const float*)d_in[12];
  in.w_s = (const float*)d_in[13]; in.b_s = (const float*)d_in[14]; in.w_ck = (const float*)d_in[15]; in.pe_ck = (const float*)d_in[16];
  in.w_cv = (const float*)d_in[17]; in.pe_cv = (const float*)d_in[18]; in.w_out = (const float*)d_in[19]; in.final_g = (const float*)d_in[20];
  P.out = (float*)d_out;
  char* ws = (char*)d_ws;
  size_t off = 1u << 20;
  auto take = [&](size_t bytes) { char* p = ws + off; off += (bytes + 255) & ~(size_t)255; return p; };
  Bufs& b = P.b;
  b.TAB = (float*)take((size_t)8192 * 16 * 4);
  b.WIN_T = (bf16_t*)take((size_t)NPAD_ * 1024 * 2);
  b.WOUT_T = (bf16_t*)take((size_t)1024 * 1024 * 2);
  b.WS_T = (bf16_t*)take((size_t)8 * 128 * 128 * 2);
  b.WCK_T = (bf16_t*)take((size_t)16 * 128 * 64 * 2);
  b.WCV_T = (bf16_t*)take((size_t)16 * 128 * 64 * 2);
  b.BIASC = (float*)take(128 * 4);
  b.HN = (bf16_t*)take((size_t)NRP_ * 1024 * 2);
  b.U = (bf16_t*)take((size_t)NRP_ * 512 * 2); b.V = (bf16_t*)take((size_t)NRP_ * 512 * 2); b.ZA = (bf16_t*)take((size_t)NRP_ * 512 * 2);
  b.Q = (bf16_t*)take((size_t)NRP_ * 512 * 2); b.ZB = (bf16_t*)take((size_t)NRP_ * 512 * 2);
  b.KS = (bf16_t*)take((size_t)NRP_ * 128 * 2); b.VS = (bf16_t*)take((size_t)NRP_ * 128 * 2);
  b.KW = (bf16_t*)take((size_t)NRP_ * 128 * 2); b.VW = (bf16_t*)take((size_t)NRP_ * 128 * 2);
  b.GATES = (float*)take((size_t)NRP_ * 32 * 4);
  b.GP = (float*)take((size_t)2 * 2 * 2 * 512 * 128 * 4);
  b.GS = (float*)take((size_t)128 * 2 * 2 * 128 * 128 * 4);
  b.MIX = (bf16_t*)take((size_t)NRP_ * 1024 * 2);
  b.H = (float*)take((size_t)NRP_ * 1024 * 4);
  b.KCCP = b.VCCP = b.KCCS = b.VCCS = nullptr;
  if (off > ws_size) { fprintf(stderr, "kernel_launch: workspace too small (%zu > %zu)\n", off, ws_size); return; }
  for (int i = 0; i < 8; ++i) P.ri.v[i] = (float)pow(500000.0, -(double)i / 8.0);
  static bool attr_done = false;
  if (!attr_done) {
    (void)hipFuncSetAttribute((const void*)k_phase0, hipFuncAttributeMaxDynamicSharedMemorySize, LDS_BYTES);
    (void)hipFuncSetAttribute((const void*)k_gemm1, hipFuncAttributeMaxDynamicSharedMemorySize, LDS_BYTES);
    (void)hipFuncSetAttribute((const void*)k_p2, hipFuncAttributeMaxDynamicSharedMemorySize, LDS_BYTES);
    (void)hipFuncSetAttribute((const void*)k_attn, hipFuncAttributeMaxDynamicSharedMemorySize, LDS_BYTES);
    (void)hipFuncSetAttribute((const void*)k_attn_s, hipFuncAttributeMaxDynamicSharedMemorySize, LDS_BYTES);
    (void)hipFuncSetAttribute((const void*)k_gemm2, hipFuncAttributeMaxDynamicSharedMemorySize, LDS_BYTES);
    attr_done = true;
  }
  k_phase0<<<256, 512, LDS_BYTES, stream>>>(P);
  k_gemm1<<<256, 512, LDS_BYTES, stream>>>(P);
  k_p2<<<673, 512, LDS_BYTES, stream>>>(P);
  k_attn<<<512, 512, LDS_BYTES, stream>>>(P);
  k_attn_s<<<256, 512, LDS_BYTES, stream>>>(P);
  k_gemm2<<<256, 512, LDS_BYTES, stream>>>(P);
  k_final<<<256, 512, 0, stream>>>(P);
}
```
